# Optimizing an MI355X kernel written in HIP

```python
import math
import jax, jax.numpy as jnp
from jax import lax
import numpy as np

D_MODEL = 1024
BATCH = 1
SEQ = 16384
DEPTH = 2

CHUNK = 64
BRANCH_WIDTH = D_MODEL // 2
MIX_WIDTH = 3 * BRANCH_WIDTH
S5_GROUP = 16
S5_GROUPS = BRANCH_WIDTH // S5_GROUP
S5_STATE = 64
RWKV_HEAD_DIM = 64
RWKV_HEADS = BRANCH_WIDTH // RWKV_HEAD_DIM
RWKV_LORA_W = 64
RWKV_LORA_A = 64
RWKV_LORA_V = 32
RWKV_GN_EPS = 64e-5
M2_HEAD_DIM = 64
M2_HEADS = BRANCH_WIDTH // M2_HEAD_DIM
M2_GROUPS = 2
M2_STATE = 128
M2_CONV = 4
M2_XBC = BRANCH_WIDTH + 2 * M2_GROUPS * M2_STATE
NORM_EPS = 1e-5

S5_COLS = (BRANCH_WIDTH, BRANCH_WIDTH)
RWKV_COLS = (BRANCH_WIDTH, BRANCH_WIDTH, BRANCH_WIDTH,
             RWKV_LORA_W, RWKV_LORA_A, BRANCH_WIDTH)
M2_COLS = (M2_XBC, M2_HEADS, BRANCH_WIDTH)
S5_PROJ = 2 * BRANCH_WIDTH
RWKV_PROJ = 4 * BRANCH_WIDTH + RWKV_LORA_W + RWKV_LORA_A
M2_PROJ = M2_XBC + M2_HEADS + BRANCH_WIDTH
PROJ_WIDTH = S5_PROJ + RWKV_PROJ + M2_PROJ

kernel_name = 'hybrid_s5_rwkv7_mamba2_parallel_heads'


def rmsnorm(x, g):
    xf = x.astype(jnp.float32)
    y = xf * lax.rsqrt(jnp.mean(xf * xf, axis=-1, keepdims=True) + NORM_EPS)
    return y * g.astype(jnp.float32)


def split_cols(t, sizes):
    offsets = np.cumsum(sizes)[:-1].tolist()
    return jnp.split(t, offsets, axis=-1)


def token_shift_lerp(t, mu):
    prev = jnp.pad(t, ((0, 0), (1, 0), (0, 0)))[:, :-1]
    return t + (prev - t) * mu.astype(jnp.float32)


def _complex_linear_combine(e1, e2):
    a1r, a1i, b1r, b1i = e1
    a2r, a2i, b2r, b2i = e2
    return (a1r * a2r - a1i * a2i,
            a1r * a2i + a1i * a2r,
            a2r * b1r - a2i * b1i + b2r,
            a2r * b1i + a2i * b1r + b2i)


def s5_mixer(u, log_dt, a_re, a_im, b_re, b_im, c_re, c_im, d_skip, w_glu, b_glu):
    f32 = jnp.float32
    bsz, seq, _ = u.shape
    uf = u.reshape(bsz, seq, S5_GROUPS, S5_GROUP)
    ar, ai = a_re.astype(f32), a_im.astype(f32)
    dt = jnp.exp(log_dt.astype(f32))[:, None]
    mag = jnp.exp(dt * ar)
    abar_re, abar_im = mag * jnp.cos(dt * ai), mag * jnp.sin(dt * ai)
    den = ar * ar + ai * ai
    f_re = ((abar_re - 1.0) * ar + abar_im * ai) / den
    f_im = (abar_im * ar - (abar_re - 1.0) * ai) / den
    br, bi = b_re.astype(f32), b_im.astype(f32)
    bb_re = f_re[..., None] * br - f_im[..., None] * bi
    bb_im = f_re[..., None] * bi + f_im[..., None] * br
    bu_re = jnp.einsum('blgc,gpc->blgp', uf, bb_re)
    bu_im = jnp.einsum('blgc,gpc->blgp', uf, bb_im)
    a_seq_re = jnp.broadcast_to(abar_re, bu_re.shape)
    a_seq_im = jnp.broadcast_to(abar_im, bu_im.shape)
    _, _, s_re, s_im = lax.associative_scan(
        _complex_linear_combine, (a_seq_re, a_seq_im, bu_re, bu_im), axis=1)
    y = (jnp.einsum('blgp,gcp->blgc', s_re, c_re.astype(f32))
         - jnp.einsum('blgp,gcp->blgc', s_im, c_im.astype(f32))
         + d_skip.astype(f32) * uf)
    y = jax.nn.gelu(y.reshape(bsz, seq, BRANCH_WIDTH))
    return y * jax.nn.sigmoid(y @ w_glu.astype(f32) + b_glu.astype(f32))


def rwkv7_recurrence(r, w, k, v, a_vec, b_vec):
    bsz, _, n_heads, n = r.shape

    def step(state, inp):
        r_t, w_t, k_t, v_t, a_t, b_t = inp
        sa = jnp.einsum('bhvk,bhk->bhv', state, a_t)
        state = (state * w_t[:, :, None, :]
                 + sa[..., None] * b_t[:, :, None, :]
                 + v_t[..., None] * k_t[:, :, None, :])
        return state, jnp.einsum('bhvk,bhk->bhv', state, r_t)

    s0 = jnp.zeros((bsz, n_heads, n, n), jnp.float32)
    xs = tuple(jnp.moveaxis(t, 1, 0) for t in (r, w, k, v, a_vec, b_vec))
    _, ys = lax.scan(step, s0, xs)
    return jnp.moveaxis(ys, 0, 1)


def rwkv7_mixer(cols, mu, w_up, w0, a_up, a0, k_k, k_a, r_k, ln_g, ln_b,
                v_first, vd_cols, vmix_mu, v_up, v0):
    f32 = jnp.float32
    bsz, seq, _ = cols.shape
    xs = token_shift_lerp(cols, mu)
    r, k, v, wd, ad, g = split_cols(xs, RWKV_COLS)
    w_log = -jax.nn.softplus(-(w0.astype(f32) + jnp.tanh(wd) @ w_up.astype(f32))) - 0.5
    decay = jnp.exp(-jnp.exp(w_log))
    a = jax.nn.sigmoid(a0.astype(f32) + ad @ a_up.astype(f32))
    if v_first is None:
        v_first = v
    else:
        vd = token_shift_lerp(vd_cols, vmix_mu)
        v = v + (v_first - v) * jax.nn.sigmoid(v0.astype(f32) + vd @ v_up.astype(f32))
    heads = lambda t: t.reshape(bsz, seq, RWKV_HEADS, RWKV_HEAD_DIM)
    kk = heads(k * k_k.astype(f32))
    kk = kk / jnp.maximum(jnp.sqrt(jnp.sum(kk * kk, axis=-1, keepdims=True)), 1e-12)
    k = k * (1.0 + (a - 1.0) * k_a.astype(f32))
    rh, kh, vh, ah = heads(r), heads(k), heads(v), heads(a)
    y = rwkv7_recurrence(rh, heads(decay), kh, vh, -kk, kk * ah)
    mean = jnp.mean(y, axis=-1, keepdims=True)
    var = jnp.mean(jnp.square(y - mean), axis=-1, keepdims=True)
    y = ((y - mean) * lax.rsqrt(var + RWKV_GN_EPS)).reshape(bsz, seq, BRANCH_WIDTH)
    y = y * ln_g.astype(f32) + ln_b.astype(f32)
    bonus = jnp.sum(rh * kh * r_k.astype(f32), axis=-1, keepdims=True) * vh
    y = y + bonus.reshape(bsz, seq, BRANCH_WIDTH)
    return y * jax.nn.silu(g), v_first


def causal_depthwise_conv(t, w, b):
    k_width, ch = w.shape
    y = lax.conv_general_dilated(
        t, w.astype(jnp.float32)[:, None, :], window_strides=(1,),
        padding=[(k_width - 1, 0)], dimension_numbers=('NWC', 'WIO', 'NWC'),
        feature_group_count=ch)
    return y + b.astype(jnp.float32)


def ssd_chunked(xdt, da, b, c):
    bsz, seq, n_heads, p = xdt.shape
    n_chunks = seq // CHUNK
    xdt = xdt.reshape(bsz, n_chunks, CHUNK, n_heads, p)
    b = b.reshape(bsz, n_chunks, CHUNK, n_heads, -1)
    c = c.reshape(bsz, n_chunks, CHUNK, n_heads, -1)
    cs = jnp.cumsum(da.reshape(bsz, n_chunks, CHUNK, n_heads), axis=2)
    seg = cs[:, :, :, None, :] - cs[:, :, None, :, :]
    causal = jnp.tril(jnp.ones((CHUNK, CHUNK), bool))[:, :, None]
    decay_in = jnp.exp(jnp.where(causal, seg, -jnp.inf))
    scores = jnp.einsum('bclhn,bcshn->bclsh', c, b) * decay_in
    y_diag = jnp.einsum('bclsh,bcshp->bclhp', scores, xdt)
    decay_to_end = jnp.exp(cs[:, :, -1:, :] - cs)
    chunk_states = jnp.einsum('bclhn,bclh,bclhp->bchpn', b, decay_to_end, xdt)
    chunk_decay = jnp.exp(cs[:, :, -1, :])

    def step(state, inp):
        s_c, g_c = inp
        return state * g_c[:, :, None, None] + s_c, state

    h0 = jnp.zeros((bsz, n_heads, p, b.shape[-1]), jnp.float32)
    _, prev = lax.scan(step, h0, (jnp.moveaxis(chunk_states, 1, 0), jnp.moveaxis(chunk_decay, 1, 0)))
    prev = jnp.moveaxis(prev, 0, 1)
    y_off = jnp.einsum('bclhn,bchpn,bclh->bclhp', c, prev, jnp.exp(cs))
    return (y_diag + y_off).reshape(bsz, seq, n_heads, p)


def mamba2_mixer(xbc, dt_raw, z, conv_w, conv_b, dt_bias, a_log, d_skip, norm_g):
    f32 = jnp.float32
    bsz, seq, _ = xbc.shape
    xbc = jax.nn.silu(causal_depthwise_conv(xbc, conv_w, conv_b))
    xm, bm, cm = split_cols(xbc, (BRANCH_WIDTH, M2_GROUPS * M2_STATE, M2_GROUPS * M2_STATE))
    heads_per_group = M2_HEADS // M2_GROUPS
    x = xm.reshape(bsz, seq, M2_HEADS, M2_HEAD_DIM)
    bm = jnp.repeat(bm.reshape(bsz, seq, M2_GROUPS, M2_STATE), heads_per_group, axis=2)
    cm = jnp.repeat(cm.reshape(bsz, seq, M2_GROUPS, M2_STATE), heads_per_group, axis=2)
    dt = jax.nn.softplus(dt_raw + dt_bias.astype(f32))
    a = -jnp.exp(a_log.astype(f32))
    y = ssd_chunked(x * dt[..., None], dt * a, bm, cm) + x * d_skip.astype(f32)[:, None]
    y = y.reshape(bsz, seq, BRANCH_WIDTH)
    return rmsnorm(y * jax.nn.silu(z), norm_g)


def setup_inputs(seed: int = 0) -> dict:
    key = jax.random.key(seed)
    ks = list(jax.random.split(key, 40))
    f32 = jnp.float32
    nrm = lambda shape, scale: scale * jax.random.normal(ks.pop(), shape, f32)
    L = DEPTH
    Lv = DEPTH - 1
    BW = BRANCH_WIDTH
    n_state = jnp.arange(S5_STATE, dtype=f32)
    lin = jnp.arange(BW, dtype=f32) / (BW - 1)
    m2_dt = jnp.exp(jax.random.uniform(ks.pop(), (L, M2_HEADS), f32, math.log(1e-3), math.log(1e-1)))
    return {
        'x': nrm((BATCH, SEQ, D_MODEL), 1.0),
        'norm_g': 1.0 + nrm((L, D_MODEL), 0.02),
        'w_in': nrm((L, D_MODEL, PROJ_WIDTH), D_MODEL ** -0.5),
        'w_in_vmix': nrm((Lv, D_MODEL, RWKV_LORA_V), D_MODEL ** -0.5),
        's5_log_dt': jax.random.uniform(ks.pop(), (L, S5_GROUPS), f32, math.log(1e-3), math.log(1e-1)),
        's5_a_re': -0.5 + nrm((L, S5_GROUPS, S5_STATE), 0.01),
        's5_a_im': math.pi * n_state + nrm((L, S5_GROUPS, S5_STATE), 0.01),
        's5_b_re': nrm((L, S5_GROUPS, S5_STATE, S5_GROUP), S5_GROUP ** -0.5),
        's5_b_im': nrm((L, S5_GROUPS, S5_STATE, S5_GROUP), S5_GROUP ** -0.5),
        's5_c_re': nrm((L, S5_GROUPS, S5_GROUP, S5_STATE), S5_STATE ** -0.5),
        's5_c_im': nrm((L, S5_GROUPS, S5_GROUP, S5_STATE), S5_STATE ** -0.5),
        's5_d': nrm((L, S5_GROUPS, S5_GROUP), 1.0),
        's5_w_glu': nrm((L, BW, BW), BW ** -0.5),
        's5_b_glu': nrm((L, BW), 0.01),
        'rwkv_mu': jax.random.uniform(ks.pop(), (L, RWKV_PROJ), f32),
        'rwkv_w_up': nrm((L, RWKV_LORA_W, BW), 0.1 * RWKV_LORA_W ** -0.5),
        'rwkv_w0': (-6.0 + 5.0 * lin ** 0.85 + 0.5) + nrm((L, BW), 0.1),
        'rwkv_a_up': nrm((L, RWKV_LORA_A, BW), 0.1 * RWKV_LORA_A ** -0.5),
        'rwkv_a0': nrm((L, BW), 0.1),
        'rwkv_k_k': 0.85 + nrm((L, BW), 0.02),
        'rwkv_k_a': 1.0 + nrm((L, BW), 0.02),
        'rwkv_r_k': -0.04 + nrm((L, RWKV_HEADS, RWKV_HEAD_DIM), 0.01),
        'rwkv_ln_g': 1.0 + nrm((L, BW), 0.02),
        'rwkv_ln_b': nrm((L, BW), 0.01),
        'rwkv_vmix_mu': jax.random.uniform(ks.pop(), (Lv, RWKV_LORA_V), f32),
        'rwkv_v_up': nrm((Lv, RWKV_LORA_V, BW), 0.1 * RWKV_LORA_V ** -0.5),
        'rwkv_v0': 1.0 + nrm((Lv, BW), 0.1),
        'm2_conv_w': nrm((L, M2_CONV, M2_XBC), 0.5),
        'm2_conv_b': nrm((L, M2_XBC), 0.01),
        'm2_dt_bias': m2_dt + jnp.log(-jnp.expm1(-m2_dt)),
        'm2_a_log': jnp.log(jax.random.uniform(ks.pop(), (L, M2_HEADS), f32, 1.0, 16.0)),
        'm2_d': 1.0 + nrm((L, M2_HEADS), 0.1),
        'm2_norm_g': 1.0 + nrm((L, BW), 0.02),
        'w_out': nrm((L, MIX_WIDTH, D_MODEL), MIX_WIDTH ** -0.5),
        'final_norm_g': 1.0 + nrm((D_MODEL,), 0.02),
    }


def reference(x, norm_g, w_in, w_in_vmix, s5_log_dt, s5_a_re, s5_a_im, s5_b_re, s5_b_im,
              s5_c_re, s5_c_im, s5_d, s5_w_glu, s5_b_glu, rwkv_mu, rwkv_w_up, rwkv_w0,
              rwkv_a_up, rwkv_a0, rwkv_k_k, rwkv_k_a, rwkv_r_k, rwkv_ln_g, rwkv_ln_b,
              rwkv_vmix_mu, rwkv_v_up, rwkv_v0, m2_conv_w, m2_conv_b, m2_dt_bias, m2_a_log,
              m2_d, m2_norm_g, w_out, final_norm_g):
    f32 = jnp.float32
    h = x
    v_first = None
    for i in range(DEPTH):
        hn = rmsnorm(h, norm_g[i])
        if i == 0:
            w_proj = w_in[i]
        else:
            w_proj = jnp.concatenate([w_in[i], w_in_vmix[i - 1]], axis=1)
        proj = hn @ w_proj.astype(f32)
        s5_cols = proj[..., :S5_PROJ]
        rw_cols = proj[..., S5_PROJ:S5_PROJ + RWKV_PROJ]
        m2_cols = proj[..., S5_PROJ + RWKV_PROJ:PROJ_WIDTH]

        u, g_s5 = split_cols(s5_cols, S5_COLS)
        y_s5 = s5_mixer(u, s5_log_dt[i], s5_a_re[i], s5_a_im[i], s5_b_re[i], s5_b_im[i],
                        s5_c_re[i], s5_c_im[i], s5_d[i], s5_w_glu[i], s5_b_glu[i]) * jax.nn.silu(g_s5)

        if i == 0:
            y_rw, v_first = rwkv7_mixer(rw_cols, rwkv_mu[i], rwkv_w_up[i], rwkv_w0[i], rwkv_a_up[i],
                                        rwkv_a0[i], rwkv_k_k[i], rwkv_k_a[i], rwkv_r_k[i],
                                        rwkv_ln_g[i], rwkv_ln_b[i], None, None, None, None, None)
        else:
            y_rw, v_first = rwkv7_mixer(rw_cols, rwkv_mu[i], rwkv_w_up[i], rwkv_w0[i], rwkv_a_up[i],
                                        rwkv_a0[i], rwkv_k_k[i], rwkv_k_a[i], rwkv_r_k[i],
                                        rwkv_ln_g[i], rwkv_ln_b[i], v_first, proj[..., PROJ_WIDTH:],
                                        rwkv_vmix_mu[i - 1], rwkv_v_up[i - 1], rwkv_v0[i - 1])

        xbc, dt_raw, z = split_cols(m2_cols, M2_COLS)
        y_m2 = mamba2_mixer(xbc, dt_raw, z, m2_conv_w[i], m2_conv_b[i], m2_dt_bias[i],
                            m2_a_log[i], m2_d[i], m2_norm_g[i])

        mixed = jnp.concatenate([y_s5, y_rw, y_m2], axis=-1)
        h = h + (mixed @ w_out[i].astype(f32)).astype(h.dtype)
    return rmsnorm(h, final_norm_g).astype(x.dtype)
```

```cpp
#include <hip/hip_runtime.h>
#include <hip/hip_cooperative_groups.h>
#include <cstdio>
namespace cg = cooperative_groups;
namespace pg8 {
#define PG8_LAS __attribute__((address_space(3)))
typedef unsigned short bf16_t;
typedef short bf16x8 __attribute__((ext_vector_type(8)));
typedef float f32x4 __attribute__((ext_vector_type(4)));
typedef unsigned u32x4 __attribute__((ext_vector_type(4)));
constexpr int BM = 256, BK = 64, HALF = 128, HTB = HALF * BK * 2  , STAGE_BYTES = 8 * HTB, NXCD = 8, WGM = 8;

__host__ __device__ __forceinline__ int lds_byte(int r, int c) { const int st = (r >> 4) * 2 + (c >> 5), rr = r & 15, cc = c & 31, ob = rr * 64 + cc * 2; return st * 1024 + (ob ^ (((ob >> 9) & 1) << 5)); }
__host__ __device__ __forceinline__ void stage_rc(int b, int& R, int& C) { const int st = b / 1024, sb = b % 1024, swz = sb ^ (((sb >> 9) & 1) << 5); R = (st >> 1) * 16 + swz / 64; C = (st & 1) * 32 + (swz % 64) / 2; }
__host__ __device__ __forceinline__ int perm32(int rho) { const int n = rho >> 4, i = rho & 15; return 8 * (i >> 2) + 4 * n + (i & 3); }

struct Unit { int pm, pn; };
struct Gemm { const bf16_t* A; const bf16_t* Bt; int M, N, K; };

struct StaticOrder {
    int nM, nN, nwg, G, c;
    __host__ __device__ void init(int M, int N, int G_, int c_) { nM = M / BM; nN = N / BM; nwg = nM * nN; G = G_; c = c_; }
    __host__ __device__ bool next(int i, Unit& u) const {
        const long L = (long)i * G + c; if (L >= nwg) return false;
        int wgid = (int)L; { const int q = nwg / NXCD, r = nwg % NXCD, xcd = wgid % NXCD, off = wgid / NXCD; wgid = (xcd < r ? xcd * (q + 1) : r * (q + 1) + (xcd - r) * q) + off; }
        const int nig = WGM * nN, gid = wgid / nig, fm = gid * WGM, gsz = (nM - fm) < WGM ? (nM - fm) : WGM;
        u.pm = fm + ((wgid % nig) % gsz); u.pn = (wgid % nig) / gsz; return true;
    }
    __device__ __forceinline__ void a_ready(const Unit&) const {}
    __device__ __forceinline__ void done(const Unit&) const {}
};
__device__ __forceinline__ unsigned cvt_pk_bf16(float lo, float hi) { unsigned r; asm volatile("v_cvt_pk_bf16_f32 %0, %1, %2" : "=v"(r) : "v"(lo), "v"(hi)); return r; }
template <class Epi, class Sched, bool STAMP = false>
__device__ __forceinline__ void gemm_phase(PG8_LAS unsigned char* lds, const Gemm g, const Sched& S, const Epi& E, unsigned long long* stamps) {
    int tid_raw = threadIdx.x; asm volatile("" : "+v"(tid_raw)); const int tid = tid_raw, wid = __builtin_amdgcn_readfirstlane(tid >> 6), lane = tid & 63, wr = wid >> 2, wc = wid & 3, fr = lane & 15, fq = lane >> 4;
    const int K = g.K, nt = K / BK;
    int ts_lo = 0, ts_hi = 0, nts = 0; const unsigned long long rt_entry = STAMP ? (unsigned long long)0ull : 0ull;
#define PG8_STAMP() do { if (STAMP && wid == 0 && nts < 64) { const unsigned long long _c = (unsigned long long)clock64(); \
        ts_lo = (lane == nts) ? (int)(unsigned)_c : ts_lo; ts_hi = (lane == nts) ? (int)(unsigned)(_c >> 32) : ts_hi; ++nts; } } while (0)
    PG8_STAMP();
    unsigned voffA[2], voffB[2];
#pragma unroll
    for (int i = 0; i < 2; ++i) { int R, C; stage_rc(tid * 16 + i * 8192, R, C); const int Rb = Epi::PERM ? ((R & ~31) + perm32(R & 31)) : R;
        voffA[i] = (unsigned)(R * K + C) * 2u; voffB[i] = (unsigned)(Rb * K + C) * 2u; }
    const size_t kstep = (size_t)(BK * 2);
    const size_t hstep = (size_t)HALF * K * 2;
    const size_t tstep = 2 * hstep;
    const unsigned ldsw = (unsigned)wid * 1024u;
    const int aoff = lds_byte(wr * 64 + fr, fq * 8), boff = lds_byte(wc * 32 + fr, fq * 8);
#define PG8_SA(b, h) (((b) * 2 + (h)) * HTB)
#define PG8_SB(b, h) ((4 + (b) * 2 + (h)) * HTB)
#define PG8_STAGE(bufoff, gbase, voff) do { _Pragma("unroll") for (int _i = 0; _i < 2; ++_i) \
        __builtin_amdgcn_global_load_lds((const unsigned*)((const char*)(gbase) + (voff)[_i]), (PG8_LAS unsigned*)(lds + (bufoff) + ldsw + _i * 8192), 16, 0, 0); } while (0)
#define PG8_LDA(dst, b, h) do { _Pragma("unroll") for (int m = 0; m < 4; ++m) _Pragma("unroll") for (int k = 0; k < 2; ++k) dst[m][k] = *(const PG8_LAS bf16x8*)(lds + PG8_SA(b, h) + aoff + m * 2048 + k * 1024); } while (0)
#define PG8_LDB(dst, b, h) do { _Pragma("unroll") for (int n = 0; n < 2; ++n) _Pragma("unroll") for (int k = 0; k < 2; ++k) dst[n][k] = *(const PG8_LAS bf16x8*)(lds + PG8_SB(b, h) + boff + n * 2048 + k * 1024); } while (0)
#define PG8_MMA(ai, bj, At, Bt) do { __builtin_amdgcn_s_setprio(1); _Pragma("unroll") for (int m = 0; m < 4; ++m) _Pragma("unroll") for (int n = 0; n < 2; ++n) _Pragma("unroll") for (int k = 0; k < 2; ++k) \
        acc[ai][bj][m][n] = __builtin_amdgcn_mfma_f32_16x16x32_bf16(Bt[n][k], At[m][k], acc[ai][bj][m][n], 0, 0, 0); __builtin_amdgcn_s_setprio(0); } while (0)
#define PG8_WAIT_V(n) asm volatile("s_waitcnt vmcnt(" #n ")" ::: "memory")
#define PG8_WAIT_L(n) asm volatile("s_waitcnt lgkmcnt(" #n ")" ::: "memory")
#define PG8_BAR __builtin_amdgcn_s_barrier()
#define PG8_SCHED __builtin_amdgcn_sched_barrier(0)
    Unit cur, nxt; int ui = 0;
    if (!S.next(0, cur)) return;
    f32x4 acc[2][2][4][2];
#pragma unroll
    for (int a = 0; a < 2; ++a)
#pragma unroll
        for (int b = 0; b < 2; ++b)
#pragma unroll
            for (int m = 0; m < 4; ++m)
#pragma unroll
                for (int n = 0; n < 2; ++n) acc[a][b][m][n] = (f32x4){0.f, 0.f, 0.f, 0.f};
    bf16x8 At[4][2], B0[2][2], B1[2][2];
    const char* cA = (const char*)g.A + (size_t)cur.pm * tstep; const char* cB = (const char*)g.Bt + (size_t)cur.pn * tstep;
    S.a_ready(cur);
    PG8_STAGE(PG8_SB(0, 0), cB, voffB); PG8_STAGE(PG8_SA(0, 0), cA, voffA); PG8_STAGE(PG8_SB(0, 1), cB + hstep, voffB); PG8_STAGE(PG8_SA(0, 1), cA + hstep, voffA);
    if (wr == 1) PG8_BAR;
    PG8_WAIT_V(4); PG8_BAR;
    PG8_STAGE(PG8_SB(1, 0), cB + kstep, voffB); PG8_STAGE(PG8_SA(1, 0), cA + kstep, voffA); PG8_STAGE(PG8_SB(1, 1), cB + hstep + kstep, voffB);
    PG8_WAIT_V(6); PG8_BAR;
    PG8_STAMP();
    for (;;) {
        const bool has_next = S.next(ui + 1, nxt);
        const char* nA = has_next ? (const char*)g.A + (size_t)nxt.pm * tstep : cA; const char* nB = has_next ? (const char*)g.Bt + (size_t)nxt.pn * tstep : cB;
        for (int t = 0; t < nt; t += 2) {
            const bool last = (t == nt - 2);
            const char* a1 = cA + (size_t)(t + 1) * kstep;
            const char* a2 = last ? nA : cA + (size_t)(t + 2) * kstep; const char* b2 = last ? nB : cB + (size_t)(t + 2) * kstep;
            const char* a3 = a2 + kstep; const char* b3 = b2 + kstep;
            if (last && has_next) S.a_ready(nxt);
            PG8_LDB(B0, 0, 0); PG8_SCHED; PG8_LDA(At, 0, 0); PG8_STAGE(PG8_SA(1, 1), a1 + hstep, voffA);
            PG8_WAIT_L(8); PG8_BAR; PG8_WAIT_L(0); PG8_MMA(0, 0, At, B0); PG8_BAR; PG8_SCHED;
            PG8_LDB(B1, 0, 1); PG8_STAGE(PG8_SB(0, 0), b2, voffB);
            PG8_BAR; PG8_WAIT_L(0); PG8_MMA(0, 1, At, B1); PG8_BAR;
            PG8_LDA(At, 0, 1); PG8_STAGE(PG8_SA(0, 0), a2, voffA);
            PG8_BAR; PG8_WAIT_L(0); PG8_MMA(1, 0, At, B0); PG8_BAR; PG8_SCHED;
            PG8_STAGE(PG8_SB(0, 1), b2 + hstep, voffB);
            PG8_WAIT_V(6); PG8_BAR; PG8_MMA(1, 1, At, B1); PG8_BAR;
            PG8_LDB(B0, 1, 0); PG8_SCHED; PG8_LDA(At, 1, 0); PG8_STAGE(PG8_SA(0, 1), a2 + hstep, voffA);
            PG8_WAIT_L(8); PG8_BAR; PG8_WAIT_L(0); PG8_MMA(0, 0, At, B0); PG8_BAR; PG8_SCHED;
            PG8_LDB(B1, 1, 1); PG8_STAGE(PG8_SB(1, 0), b3, voffB);
            PG8_BAR; PG8_WAIT_L(0); PG8_MMA(0, 1, At, B1); PG8_BAR;
            PG8_LDA(At, 1, 1); PG8_STAGE(PG8_SA(1, 0), a3, voffA);
            PG8_BAR; PG8_WAIT_L(0); PG8_MMA(1, 0, At, B0); PG8_BAR; PG8_SCHED;
            PG8_STAGE(PG8_SB(1, 1), b3 + hstep, voffB);
            PG8_WAIT_V(6); PG8_BAR; PG8_MMA(1, 1, At, B1); PG8_BAR;
        }
        PG8_STAMP();
        if constexpr (!Epi::AFTER_DRAIN) { E(acc, cur, wr, wc, fr, fq); S.done(cur); }
        PG8_STAMP();
        if (!has_next) break;
#pragma unroll
        for (int a = 0; a < 2; ++a)
#pragma unroll
            for (int b = 0; b < 2; ++b)
#pragma unroll
                for (int m = 0; m < 4; ++m)
#pragma unroll
                    for (int n = 0; n < 2; ++n) acc[a][b][m][n] = (f32x4){0.f, 0.f, 0.f, 0.f};
        cur = nxt; cA = nA; cB = nB; ++ui;
    }
    PG8_WAIT_V(0);
    if (wr == 0) PG8_BAR;
    PG8_BAR;
    if constexpr (Epi::AFTER_DRAIN) { E.fused(acc, cur, wr, wc, fr, fq, lds, wid, lane); S.done(cur); }
    PG8_STAMP();
    if (STAMP && wid == 0) { stamps[lane] = lane < nts ? (((unsigned long long)(unsigned)ts_hi << 32) | (unsigned)ts_lo) : 0ull;
        if (lane == 62) stamps[62] = rt_entry; if (lane == 63) stamps[63] = (unsigned long long)0ull; }
#undef PG8_STAMP
#undef PG8_SA
#undef PG8_SB
#undef PG8_STAGE
#undef PG8_LDA
#undef PG8_LDB
#undef PG8_MMA
#undef PG8_WAIT_V
#undef PG8_WAIT_L
#undef PG8_BAR
#undef PG8_SCHED
}
}

#define LAS __attribute__((address_space(3)))
#ifndef DBG_ZERO
#define DBG_ZERO 0
#endif
#define DBG_NORW ((DBG_ZERO >> 1) & 1)
#ifndef DBG_RWS0
#define DBG_RWS0 0
#endif
#ifndef DBG_SLOWM
#define DBG_SLOWM 0
#endif
#ifndef DBG_SLOWR
#define DBG_SLOWR 0
#endif
#ifndef DBG_SLOWS
#define DBG_SLOWS 0
#endif
#ifndef DBG_DBL
#define DBG_DBL 0
#endif
#ifndef DBG_PROBE
#define DBG_PROBE 0
#endif
#ifndef DBG_MASK
#define DBG_MASK 0xfff
#endif
#ifndef DBG_FINAL
#define DBG_FINAL 2
#endif
typedef unsigned short bf16_t;
typedef short bf16x8 __attribute__((ext_vector_type(8)));
typedef float f32x4 __attribute__((ext_vector_type(4)));
typedef float f32x16 __attribute__((ext_vector_type(16)));
typedef unsigned u32x4 __attribute__((ext_vector_type(4)));
typedef unsigned u32x2 __attribute__((ext_vector_type(2)));

constexpr int L_ = 16384, D_ = 1024, NCH = 256;
constexpr int PW = 4744, PSTR = 4800, NPAD = 4864;
constexpr int C_S5U = 0, C_S5G = 512, C_RW = 1024, C_R = 1024, C_K = 1536, C_V = 2048, C_WD = 2560, C_AD = 2624, C_G = 2688;
constexpr int C_X = 3200, C_B = 3712, C_C = 3968, C_DT = 4224, C_Z = 4232, C_VD = 4744;
constexpr int MIXW = 1536;
constexpr int TEAM_LDS = 75776;
constexpr int LDS_BYTES = 2 * TEAM_LDS + 512;

constexpr size_t OFF_PROJ = 0;
constexpr size_t OFF_R1   = OFF_PROJ + (size_t)L_ * PSTR * 2;
constexpr size_t OFF_D0   = OFF_R1 + (size_t)L_ * 1024 * 2;
constexpr size_t OFF_VF   = OFF_D0 + (size_t)L_ * 1024 * 2;
constexpr size_t OFF_WIN  = OFF_VF + (size_t)L_ * 512 * 2;
constexpr size_t OFF_WOUT = OFF_WIN + (size_t)NPAD * 1024 * 2;
constexpr size_t OFF_WGLU = OFF_WOUT + (size_t)1024 * 1536 * 2;
constexpr size_t OFF_WUP  = OFF_WGLU + (size_t)512 * 512 * 2;
constexpr size_t OFF_AUP  = OFF_WUP + 512 * 64 * 2;
constexpr size_t OFF_VUP  = OFF_AUP + 512 * 64 * 2;
constexpr size_t OFF_BB   = OFF_VUP + 512 * 64 * 2;
constexpr size_t OFF_CC   = OFF_BB + 32 * 128 * 16 * 2;
constexpr size_t OFF_ABAR = OFF_CC + 32 * 32 * 128 * 2;
constexpr size_t OFF_AB64 = OFF_ABAR + 2048 * 8;
constexpr size_t OFF_GDEC = OFF_AB64 + 2048 * 8;
constexpr size_t OFF_SSQ  = OFF_GDEC + 2048 * 4;
constexpr size_t OFF_S5E  = OFF_SSQ + (size_t)L_ * 8 * 4;
constexpr size_t OFF_BAR  = OFF_S5E + (size_t)256 * 2048 * 8;
constexpr size_t WS_END   = OFF_BAR + 256;
constexpr size_t OUT_MIX = 0, OUT_SEN = (size_t)L_ * MIXW * 2;

__device__ __forceinline__ int ltid() { int t = threadIdx.x; asm volatile("" : "+v"(t)); return t; }
__device__ __forceinline__ int lane_id_opaque() { int l = __builtin_amdgcn_mbcnt_hi(-1, __builtin_amdgcn_mbcnt_lo(-1, 0)); asm volatile("" : "+v"(l)); return l; }
__device__ __forceinline__ float shx(float v, int m) { return __int_as_float(__builtin_amdgcn_ds_bpermute((lane_id_opaque() ^ m) << 2, __float_as_int(v))); }
__device__ __forceinline__ float shup(float v, int d) { const int l = lane_id_opaque(); return __int_as_float(__builtin_amdgcn_ds_bpermute((l >= d ? l - d : l) << 2, __float_as_int(v))); }
__device__ __forceinline__ void grid_bar(unsigned* cnt, unsigned target) {
    __threadfence();
    __syncthreads();
    if (ltid() == 0) {
        __hip_atomic_fetch_add(cnt, 1u, __ATOMIC_RELEASE, __HIP_MEMORY_SCOPE_AGENT);
        while (__hip_atomic_load(cnt, __ATOMIC_ACQUIRE, __HIP_MEMORY_SCOPE_AGENT) < target) __builtin_amdgcn_s_sleep(2);
    }
    __syncthreads();
    __threadfence();
}
struct Params { const float* in[35]; float* out; unsigned char* ws; };
constexpr int PTAB_OFF = 2 * 75776;
struct Ctx { LAS const unsigned* tab; float* out; unsigned char* ws;
    __device__ __forceinline__ unsigned char* wsp() const { unsigned char* w = ws; asm volatile("" : "+s"(w)); return w; }
    __device__ __forceinline__ unsigned char* outp() const { unsigned char* w = (unsigned char*)out; asm volatile("" : "+s"(w)); return w; }
    __device__ __forceinline__ const float* in(int k) const { int off = 2 * k; asm volatile("" : "+s"(off)); LAS const unsigned* q = tab + off;
        const unsigned lo = __builtin_amdgcn_readfirstlane(q[0]), hi = __builtin_amdgcn_readfirstlane(q[1]);
        return (const float*)(((unsigned long long)hi << 32) | lo); } };

typedef __bf16 bf16x2_n __attribute__((ext_vector_type(2)));
typedef float f32x2_n __attribute__((ext_vector_type(2)));
__device__ __forceinline__ bf16_t f2bf(float f) { const __bf16 b = (__bf16)f; return __builtin_bit_cast(unsigned short, b); }
__device__ __forceinline__ float bf2f(unsigned b) { return __uint_as_float(b << 16); }
__device__ __forceinline__ unsigned pack2(float lo, float hi) { const f32x2_n v = {lo, hi}; const bf16x2_n b = __builtin_convertvector(v, bf16x2_n); return __builtin_bit_cast(unsigned, b); }
__device__ __forceinline__ float sigmoidf_(float x) { return 1.0f / (1.0f + __expf(-x)); }
__device__ __forceinline__ float siluf_(float x) { return x / (1.0f + __expf(-x)); }
__device__ __forceinline__ float softplusf_(float z) { return z > 20.f ? z : log1pf(__expf(z)); }
__device__ __forceinline__ void unpack8(u32x4 v, float* o) {
#pragma unroll
    for (int i = 0; i < 4; ++i) { o[2 * i] = __uint_as_float(v[i] << 16); o[2 * i + 1] = __uint_as_float(v[i] & 0xffff0000u); }
}
__device__ __forceinline__ u32x4 pack8(const float* o) { u32x4 v; v.x = pack2(o[0], o[1]); v.y = pack2(o[2], o[3]); v.z = pack2(o[4], o[5]); v.w = pack2(o[6], o[7]); return v; }
__device__ __forceinline__ void ld16(const bf16_t* p, float* o) { u32x4 a = *(const u32x4*)p, b = *(const u32x4*)(p + 8); unpack8(a, o); unpack8(b, o + 8); }
__device__ __forceinline__ void ld16_lerp(const bf16_t* crow, const bf16_t* prow, const float* mu, float* o) {
    float c[16], q[16]; ld16(crow, c);
    if (prow) ld16(prow, q); else {
#pragma unroll
        for (int i = 0; i < 16; ++i) q[i] = 0.f; }
#pragma unroll
    for (int i = 0; i < 16; ++i) o[i] = c[i] + (q[i] - c[i]) * mu[i];
}
__device__ __forceinline__ void ld8_lerp(const bf16_t* crow, const bf16_t* prow, const float* mu, float* o) {
    float c[8], q[8]; unpack8(*(const u32x4*)crow, c);
    if (prow) unpack8(*(const u32x4*)prow, q); else {
#pragma unroll
        for (int i = 0; i < 8; ++i) q[i] = 0.f; }
#pragma unroll
    for (int i = 0; i < 8; ++i) o[i] = c[i] + (q[i] - c[i]) * mu[i];
}
__device__ __forceinline__ void st16_lds(LAS bf16_t* p, const float* o) { *(LAS u32x4*)p = pack8(o); *(LAS u32x4*)(p + 8) = pack8(o + 8); }
__device__ __forceinline__ void st16_g(bf16_t* p, const float* o) { *(u32x4*)p = pack8(o); *(u32x4*)(p + 8) = pack8(o + 8); }

__device__ __forceinline__ f32x16 mma_ll(f32x16 acc, const LAS bf16_t* A, int lda, const LAS bf16_t* B, int ldb, int K, int lane) {
    const LAS bf16_t* pa = A + (lane & 31) * lda + 8 * (lane >> 5);
    const LAS bf16_t* pb = B + (lane & 31) * ldb + 8 * (lane >> 5);
#pragma unroll 4
    for (int k = 0; k < K; k += 16) { bf16x8 a = *(const LAS bf16x8*)(pa + k); bf16x8 b = *(const LAS bf16x8*)(pb + k); acc = __builtin_amdgcn_mfma_f32_32x32x16_bf16(a, b, acc, 0, 0, 0); }
    return acc;
}
__device__ __forceinline__ f32x16 mma_lg(f32x16 acc, const LAS bf16_t* A, int lda, const bf16_t* B, int ldb, int K, int lane) {
    const LAS bf16_t* pa = A + (lane & 31) * lda + 8 * (lane >> 5);
    const bf16_t* pb = B + (size_t)(lane & 31) * ldb + 8 * (lane >> 5);
#pragma unroll 4
    for (int k = 0; k < K; k += 16) { bf16x8 a = *(const LAS bf16x8*)(pa + k); bf16x8 b = *(const bf16x8*)(pb + k); acc = __builtin_amdgcn_mfma_f32_32x32x16_bf16(a, b, acc, 0, 0, 0); }
    return acc;
}
__device__ __forceinline__ f32x16 mma_gg(f32x16 acc, const bf16_t* A, int lda, const bf16_t* B, int ldb, int K, int lane) {
    const bf16_t* pa = A + (size_t)(lane & 31) * lda + 8 * (lane >> 5);
    const bf16_t* pb = B + (size_t)(lane & 31) * ldb + 8 * (lane >> 5);
#pragma unroll 4
    for (int k = 0; k < K; k += 16) { bf16x8 a = *(const bf16x8*)(pa + k); bf16x8 b = *(const bf16x8*)(pb + k); acc = __builtin_amdgcn_mfma_f32_32x32x16_bf16(a, b, acc, 0, 0, 0); }
    return acc;
}
#define ACC_ROW(j, lane) (((j) & 3) + 8 * ((j) >> 2) + 4 * ((lane) >> 5))
__device__ __forceinline__ f32x16 zero16() { f32x16 z;
#pragma unroll
    for (int i = 0; i < 16; ++i) z[i] = 0.f; return z; }

using pg8::Unit; using pg8::BM; using pg8::HALF;
struct EpiProj {
    static constexpr bool PERM = true, AFTER_DRAIN = false;
    bf16_t* O;
    __device__ __forceinline__ void operator()(const f32x4 (&acc)[2][2][4][2], const Unit& u, int wr, int wc, int fr, int fq) const {
        const int row0 = u.pm * BM + wr * 64 + fr, col0 = u.pn * BM + wc * 32 + 8 * fq;
#pragma unroll
        for (int ai = 0; ai < 2; ++ai)
#pragma unroll
            for (int m = 0; m < 4; ++m) { bf16_t* rowp = O + (size_t)(row0 + ai * HALF + m * 16) * PSTR + col0;
#pragma unroll
                for (int bj = 0; bj < 2; ++bj) { const f32x4 v0 = acc[ai][bj][m][0], v1 = acc[ai][bj][m][1];
                    u32x4 w; w.x = pack2(v0[0], v0[1]); w.y = pack2(v0[2], v0[3]); w.z = pack2(v1[0], v1[1]); w.w = pack2(v1[2], v1[3]);
                    if (col0 + bj * HALF < PSTR) *(u32x4*)(rowp + bj * HALF) = w; } }
    }
};
struct EpiD0 {
    static constexpr bool PERM = true, AFTER_DRAIN = false;
    bf16_t* O;
    __device__ __forceinline__ void operator()(const f32x4 (&acc)[2][2][4][2], const Unit& u, int wr, int wc, int fr, int fq) const {
        const int row0 = u.pm * BM + wr * 64 + fr, col0 = u.pn * BM + wc * 32 + 8 * fq;
#pragma unroll
        for (int ai = 0; ai < 2; ++ai)
#pragma unroll
            for (int m = 0; m < 4; ++m) { bf16_t* rowp = O + (size_t)(row0 + ai * HALF + m * 16) * 1024 + col0;
#pragma unroll
                for (int bj = 0; bj < 2; ++bj) { const f32x4 v0 = acc[ai][bj][m][0], v1 = acc[ai][bj][m][1];
                    u32x4 w; w.x = pack2(v0[0], v0[1]); w.y = pack2(v0[2], v0[3]); w.z = pack2(v1[0], v1[1]); w.w = pack2(v1[2], v1[3]);
                    *(u32x4*)(rowp + bj * HALF) = w; } }
    }
};
struct EpiH2 {
    static constexpr bool PERM = false, AFTER_DRAIN = false;
    float* O;
    __device__ __forceinline__ void operator()(const f32x4 (&acc)[2][2][4][2], const Unit& u, int wr, int wc, int fr, int fq) const {
        const int row0 = u.pm * BM + wr * 64 + fr, col0 = u.pn * BM + wc * 32 + 4 * fq;
#pragma unroll
        for (int ai = 0; ai < 2; ++ai)
#pragma unroll
            for (int m = 0; m < 4; ++m) { float* rowp = O + (size_t)(row0 + ai * HALF + m * 16) * 1024 + col0;
#pragma unroll
                for (int bj = 0; bj < 2; ++bj)
#pragma unroll
                    for (int n = 0; n < 2; ++n) *(f32x4*)(rowp + bj * HALF + n * 16) = acc[ai][bj][m][n]; }
    }
};
struct EpiGlu {
    static constexpr bool PERM = true, AFTER_DRAIN = false;
    bf16_t* MIX; const bf16_t* Y; const bf16_t* PROJ; const float* bias;
    __device__ __forceinline__ void operator()(const f32x4 (&acc)[2][2][4][2], const Unit& u, int wr, int wc, int fr, int fq) const {
        const int row0 = u.pm * BM + wr * 64 + fr, col0 = u.pn * BM + wc * 32 + 8 * fq;
#pragma unroll
        for (int ai = 0; ai < 2; ++ai)
#pragma unroll
            for (int m = 0; m < 4; ++m) { const int row = row0 + ai * HALF + m * 16;
#pragma unroll
                for (int bj = 0; bj < 2; ++bj) { const int col = col0 + bj * HALF;
                    float z[8], y[8], g[8], o[8];
                    const f32x4 v0 = acc[ai][bj][m][0], v1 = acc[ai][bj][m][1];
#pragma unroll
                    for (int e = 0; e < 4; ++e) { z[e] = v0[e] + bias[col + e]; z[4 + e] = v1[e] + bias[col + 4 + e]; }
                    unpack8(*(const u32x4*)(Y + (size_t)row * 512 + col), y);
                    unpack8(*(const u32x4*)(PROJ + (size_t)row * PSTR + C_S5G + col), g);
#pragma unroll
                    for (int e = 0; e < 8; ++e) o[e] = (DBG_ZERO & 1) ? 0.f : ((DBG_DBL & 1) ? 2.f : 1.f) * y[e] * sigmoidf_(z[e]) * siluf_(g[e]);
                    *(u32x4*)(MIX + (size_t)row * MIXW + col) = pack8(o); } }
    }
};

__device__ __forceinline__ void tconv(bf16_t* dst, int N, int K, const float* src1, int ld1, int n1, const float* src2, int ld2, int n2, int kvalid,
                      const float* sc, int ks0, LAS float* tile, int& rot) {
    const int tid = ltid(); const int tn = N / 64, tk = K / 64, nt = tn * tk;
    for (int t = (blockIdx.x + rot) % gridDim.x; t < nt; t += gridDim.x) {
        const int n0 = (t % tn) * 64, k0 = (t / tn) * 64;
#pragma unroll
        for (int e = 0; e < 8; ++e) { const int idx = e * 512 + tid, kk = idx >> 6, nn = idx & 63, k = k0 + kk, n = n0 + nn;
            float v = 0.f;
            if (k < kvalid) { if (n < n1) v = src1[(size_t)k * ld1 + n]; else if (src2 && n < n2) v = src2[(size_t)k * ld2 + (n - n1)]; }
            if (sc && k >= ks0) v *= sc[k - ks0];
            tile[kk * 65 + nn] = v; }
        __syncthreads();
        { const int n = tid >> 3, ks = (tid & 7) * 8; float o[8];
#pragma unroll
          for (int j = 0; j < 8; ++j) o[j] = tile[(ks + j) * 65 + n];
          *(u32x4*)(dst + (size_t)(n0 + n) * K + k0 + ks) = pack8(o); }
        __syncthreads();
    }
    rot += nt;
}

__device__ __forceinline__ void phase_prep(const Ctx& p, int layer, LAS unsigned char* lds) {
    unsigned char* ws = p.wsp(); const int tid = ltid(), lane = tid & 63;
    LAS float* tile = (LAS float*)lds; int rot = 0;
    tconv((bf16_t*)(ws + OFF_WIN), NPAD, 1024, p.in(2) + (size_t)layer * 1024 * PW, PW, PW, layer ? p.in(3) : nullptr, 32, PW + 32, 1024, p.in(1) + layer * 1024, 0, tile, rot);
    tconv((bf16_t*)(ws + OFF_WOUT), 1024, 1536, p.in(33) + (size_t)layer * 1536 * 1024, 1024, 1024, nullptr, 0, 0, 1536, p.in(32) + layer * 512, 1024, tile, rot);
    tconv((bf16_t*)(ws + OFF_WGLU), 512, 512, p.in(12) + (size_t)layer * 512 * 512, 512, 512, nullptr, 0, 0, 512, nullptr, 0, tile, rot);
    tconv((bf16_t*)(ws + OFF_WUP), 512, 64, p.in(15) + (size_t)layer * 64 * 512, 512, 512, nullptr, 0, 0, 64, nullptr, 0, tile, rot);
    tconv((bf16_t*)(ws + OFF_AUP), 512, 64, p.in(17) + (size_t)layer * 64 * 512, 512, 512, nullptr, 0, 0, 64, nullptr, 0, tile, rot);
    if (layer) tconv((bf16_t*)(ws + OFF_VUP), 512, 64, p.in(25), 512, 512, nullptr, 0, 0, 32, nullptr, 0, tile, rot);
    { const int gt = blockIdx.x * 512 + tid;
      if (gt < 2048) { const int g = gt >> 6, pp = gt & 63;
        const float dt = expf(p.in(4)[layer * 32 + g]); const float ar = p.in(5)[layer * 2048 + gt], ai = p.in(6)[layer * 2048 + gt];
        const float mag = expf(dt * ar); const float abr = mag * cosf(dt * ai), abi = mag * sinf(dt * ai);
        const float den = ar * ar + ai * ai; const float fre = ((abr - 1.0f) * ar + abi * ai) / den, fim = (abi * ar - (abr - 1.0f) * ai) / den;
        bf16_t* BB = (bf16_t*)(ws + OFF_BB); bf16_t* CC = (bf16_t*)(ws + OFF_CC);
        const float* br = p.in(7) + (size_t)layer * 32768 + (size_t)gt * 16; const float* bi = p.in(8) + (size_t)layer * 32768 + (size_t)gt * 16;
#pragma unroll 1
        for (int c = 0; c < 16; ++c) { BB[(g * 128 + pp) * 16 + c] = f2bf(fre * br[c] - fim * bi[c]); BB[(g * 128 + 64 + pp) * 16 + c] = f2bf(fre * bi[c] + fim * br[c]); }
        const float* cr = p.in(9) + (size_t)layer * 32768 + (size_t)g * 1024; const float* ci = p.in(10) + (size_t)layer * 32768 + (size_t)g * 1024;
#pragma unroll 1
        for (int c = 0; c < 32; ++c) { CC[(g * 32 + c) * 128 + pp] = c < 16 ? f2bf(cr[c * 64 + pp]) : (bf16_t)0; CC[(g * 32 + c) * 128 + 64 + pp] = c < 16 ? f2bf(-ci[c * 64 + pp]) : (bf16_t)0; }
        float2* AB = (float2*)(ws + OFF_ABAR); float2* AB64 = (float2*)(ws + OFF_AB64);
        AB[gt] = make_float2(abr, abi);
        float xr = abr, xi = abi;
#pragma unroll 1
        for (int s = 0; s < 6; ++s) { const float nr = xr * xr - xi * xi, ni = 2.f * xr * xi; xr = nr; xi = ni; }
        AB64[gt] = make_float2(xr, xi); } }
    { const float* x = p.in(0); const bf16_t* D0 = (const bf16_t*)(ws + OFF_D0); bf16_t* hb = (bf16_t*)(ws + OFF_R1);
      const int wv = blockIdx.x * 8 + (tid >> 6), nw = gridDim.x * 8;
      for (int t = wv; t < L_; t += nw) {
          float v[16]; float ss = 0.f;
#pragma unroll
          for (int j = 0; j < 4; ++j) { const size_t o = (size_t)t * 1024 + j * 256 + lane * 4; f32x4 xv = *(const f32x4*)(x + o);
              if (layer) { const u32x2 dv = *(const u32x2*)(D0 + o); xv[0] += __uint_as_float(dv.x << 16); xv[1] += __uint_as_float(dv.x & 0xffff0000u); xv[2] += __uint_as_float(dv.y << 16); xv[3] += __uint_as_float(dv.y & 0xffff0000u); }
#pragma unroll
              for (int e = 0; e < 4; ++e) { v[j * 4 + e] = xv[e]; ss += xv[e] * xv[e]; } }
#pragma unroll
          for (int o = 32; o > 0; o >>= 1) ss += shx(ss, o);
          const float rs = rsqrtf(ss * (1.0f / 1024.0f) + 1e-5f);
#pragma unroll
          for (int j = 0; j < 4; ++j) { u32x2 w; w.x = pack2(v[j * 4] * rs, v[j * 4 + 1] * rs); w.y = pack2(v[j * 4 + 2] * rs, v[j * 4 + 3] * rs);
              *(u32x2*)(hb + (size_t)t * 1024 + j * 256 + lane * 4) = w; } } }
}


#if DBG_PROBE
__device__ __forceinline__ void phase_probe(const Ctx& p) {
    unsigned char* ws = p.wsp(); bf16_t* R = (bf16_t*)(ws + OFF_R1);
    const bf16_t* PROJ = (const bf16_t*)(ws + OFF_PROJ); const bf16_t* MIX = (const bf16_t*)(p.outp() + OUT_MIX);
    const bf16_t* YB = (const bf16_t*)(p.outp() + OUT_SEN); const bf16_t* D0 = (const bf16_t*)(ws + OFF_D0);
    const float* SSQ = (const float*)(ws + OFF_SSQ);
    const size_t n = (size_t)L_ * 1024;
    for (size_t i = (size_t)blockIdx.x * 512 + ltid(); i < n; i += (size_t)gridDim.x * 512) {
        const int t = (int)(i >> 10), c = (int)(i & 1023); float v = 0.f;
        if (DBG_PROBE == 1) { for (int k = 0; k < 4; ++k) v += bf2f(PROJ[(size_t)t * PSTR + c + 1024 * k]); if (c < 704) v += bf2f(PROJ[(size_t)t * PSTR + 4096 + c]); }
        if (DBG_PROBE == 2) v = bf2f(MIX[(size_t)t * MIXW + (c & 511)]);
        if (DBG_PROBE == 3) v = bf2f(MIX[(size_t)t * MIXW + 512 + (c & 511)]);
        if (DBG_PROBE == 4) v = bf2f(MIX[(size_t)t * MIXW + 1024 + (c & 511)]);
        if (DBG_PROBE == 5) v = bf2f(D0[i]);
        if (DBG_PROBE == 6) v = bf2f(YB[(size_t)t * 512 + (c & 511)]);
        if (DBG_PROBE == 7) v = SSQ[t * 8 + (c & 7)];
        if (DBG_PROBE == 8) v = bf2f(((const bf16_t*)(ws + OFF_WIN))[i]) + bf2f(((const bf16_t*)(ws + OFF_WOUT))[i & (1024 * 1536 - 1)]);
        if (DBG_PROBE == 9) v = ((const float*)(ws + OFF_S5E))[i & (1048576 - 1)];
        if (DBG_PROBE == 10) v = bf2f(((const bf16_t*)(ws + OFF_BB))[i & 65535]) + bf2f(((const bf16_t*)(ws + OFF_CC))[i & 131071]) + ((const float*)(ws + OFF_ABAR))[i & 4095] + ((const float*)(ws + OFF_AB64))[i & 4095];
        R[i] = f2bf(v);
    }
}
#endif
__device__ __forceinline__ void phase_final(const Ctx& p) {
    const float* h2 = (const float*)(p.wsp() + OFF_PROJ); const float* g = p.in(34); float* out = p.out; const float* x = p.in(0); const bf16_t* D0 = (const bf16_t*)(p.wsp() + OFF_D0);
    const int tid = ltid(), lane = tid & 63; const int wv = blockIdx.x * 8 + (tid >> 6), nw = gridDim.x * 8;
    for (int t = wv; t < L_; t += nw) {
        f32x4 v[4]; float ss = 0.f;
#pragma unroll
        for (int j = 0; j < 4; ++j) { const size_t o = (size_t)t * 1024 + j * 256 + lane * 4; v[j] = *(const f32x4*)(x + o);
#if DBG_PROBE
            u32x2 dv = *(const u32x2*)((const bf16_t*)(p.wsp() + OFF_R1) + o);
#else
            u32x2 dv = *(const u32x2*)(D0 + o);
#endif
#if DBG_FINAL >= 2 && !DBG_PROBE
            v[j] += *(const f32x4*)(h2 + o);
#endif
#if DBG_FINAL < 1 && !DBG_PROBE
            dv.x = 0; dv.y = 0;
#endif

            v[j][0] += __uint_as_float(dv.x << 16); v[j][1] += __uint_as_float(dv.x & 0xffff0000u); v[j][2] += __uint_as_float(dv.y << 16); v[j][3] += __uint_as_float(dv.y & 0xffff0000u); ss += v[j][0] * v[j][0] + v[j][1] * v[j][1] + v[j][2] * v[j][2] + v[j][3] * v[j][3]; }
#pragma unroll
        for (int o = 32; o > 0; o >>= 1) ss += shx(ss, o);
        const float rs = rsqrtf(ss * (1.0f / 1024.0f) + 1e-5f);
#pragma unroll
        for (int j = 0; j < 4; ++j) { const f32x4 gv = *(const f32x4*)(g + j * 256 + lane * 4); *(f32x4*)(out + (size_t)t * 1024 + j * 256 + lane * 4) = v[j] * rs * gv; }
    }
}

__device__ __forceinline__ void m2_normalize(const Ctx& p, int b0, int nb) {
    bf16_t* mix = (bf16_t*)(p.outp() + OUT_MIX); const float* ssq = (const float*)(p.wsp() + OFF_SSQ);
    const int tid = ltid(), lane = tid & 63; const int wv = (blockIdx.x - b0) * 8 + (tid >> 6), nw = nb * 8;
    for (int t = wv; t < L_; t += nw) {
        float s = 0.f;
#pragma unroll
        for (int h = 0; h < 8; ++h) s += ssq[t * 8 + h];
        const float rs = ((DBG_DBL & 4) ? 2.f : 1.f) * rsqrtf(s * (1.0f / 512.0f) + 1e-5f);
        bf16_t* ptr = mix + (size_t)t * MIXW + 1024 + lane * 8; float o[8]; unpack8(*(const u32x4*)ptr, o);
#pragma unroll
        for (int e = 0; e < 8; ++e) o[e] *= rs;
        *(u32x4*)ptr = pack8(o);
    }
}

constexpr int TS = 72;
constexpr int FS = 68;
template <int PASS>
__device__ __forceinline__ void rwkv_pass(const Ctx& p, int layer, LAS unsigned char* tl, int team_gid, int nteams) {
    unsigned char* ws = p.wsp();
    const int tt0 = ltid() & 255;
    const bf16_t* PROJ = (const bf16_t*)(ws + OFF_PROJ);
    bf16_t* MtG = (bf16_t*)(ws + OFF_R1); bf16_t* NG = MtG + (size_t)2048 * 4096;
    bf16_t* SEN = (bf16_t*)(p.outp() + OUT_SEN);
    bf16_t* MIX = (bf16_t*)(p.outp() + OUT_MIX);
    bf16_t* VF = (bf16_t*)(ws + OFF_VF);
    const bf16_t* WUP = (const bf16_t*)(ws + OFF_WUP); const bf16_t* AUP = (const bf16_t*)(ws + OFF_AUP); const bf16_t* VUP = (const bf16_t*)(ws + OFF_VUP);
    const float* mu = p.in(14) + layer * 2176;
    LAS float* PT = (LAS float*)(tl + 73728);
    LAS bf16_t* TW = (LAS bf16_t*)(tl + 0); LAS bf16_t* TA = (LAS bf16_t*)(tl + 9216); LAS bf16_t* TV = (LAS bf16_t*)(tl + 18432);
    LAS float* LW = (LAS float*)(tl + 27648); LAS bf16_t* AS = (LAS bf16_t*)(tl + 45056); LAS bf16_t* SV = (LAS bf16_t*)(tl + 54272);
    LAS bf16_t* At = (LAS bf16_t*)(tl + (PASS == 1 ? 0 : 36864));
    LAS bf16_t* VT = (LAS bf16_t*)(tl + 9216);
    LAS bf16_t* BT = (LAS bf16_t*)(tl + 18432);
    LAS bf16_t* KT = (LAS bf16_t*)(tl + 27648);
    LAS bf16_t* Rn = (LAS bf16_t*)(tl + 0);
    LAS bf16_t* Bn = (LAS bf16_t*)(tl + (PASS == 1 ? 36864 : 18432));
    LAS bf16_t* Kn = (LAS bf16_t*)(tl + (PASS == 1 ? 46080 : 27648));
    LAS float* AAB = (LAS float*)(tl + (PASS == 1 ? 36864 : 18432));
    LAS bf16_t* AK = (LAS bf16_t*)(tl + (PASS == 1 ? 55296 : 46080));
    LAS float* XF = (LAS float*)(tl + (PASS == 1 ? 55296 : 36864));
    LAS bf16_t* UT0 = (LAS bf16_t*)(tl + (PASS == 1 ? 55296 : 36864));
    LAS bf16_t* UT1 = (LAS bf16_t*)(tl + 64512);
    LAS bf16_t* ARB = (LAS bf16_t*)(tl + 55296); LAS bf16_t* ARK = (LAS bf16_t*)(tl + 64512);

    for (int item = team_gid; item < 2048; item += nteams) {
        const int c = item >> 3, h = item & 7, t0 = c * 64;
        int tt = tt0; asm volatile("" : "+v"(tt));
        const int wq = __builtin_amdgcn_readfirstlane(tt >> 6), lane = tt & 63, ti = wq >> 1, tj = wq & 1;
        const int t = tt >> 2, seg = tt & 3, gt = t0 + t;
        const bf16_t* crow = PROJ + (size_t)gt * PSTR; const bf16_t* prow = gt > 0 ? crow - PSTR : nullptr;
        { float o[16];
          ld16_lerp(crow + C_WD + seg * 16, prow ? prow + C_WD + seg * 16 : nullptr, mu + (C_WD - C_RW) + seg * 16, o);
#pragma unroll
          for (int e = 0; e < 16; ++e) o[e] = tanhf(o[e]);
          st16_lds(TW + t * TS + seg * 16, o);
          ld16_lerp(crow + C_AD + seg * 16, prow ? prow + C_AD + seg * 16 : nullptr, mu + (C_AD - C_RW) + seg * 16, o);
          st16_lds(TA + t * TS + seg * 16, o);
          if (layer) { if (seg < 2) ld16_lerp(crow + C_VD + seg * 16, prow ? prow + C_VD + seg * 16 : nullptr, p.in(24) + seg * 16, o); else {
#pragma unroll
                  for (int e = 0; e < 16; ++e) o[e] = 0.f; }
              st16_lds(TV + t * TS + seg * 16, o); } }
        __syncthreads();
        { f32x16 aw = mma_lg(zero16(), TW + ti * 32 * TS, TS, WUP + (size_t)(64 * h + tj * 32) * 64, 64, 64, lane);
          f32x16 aa = mma_lg(zero16(), TA + ti * 32 * TS, TS, AUP + (size_t)(64 * h + tj * 32) * 64, 64, 64, lane);
          f32x16 av = zero16(); if (layer) av = mma_lg(av, TV + ti * 32 * TS, TS, VUP + (size_t)(64 * h + tj * 32) * 64, 64, 64, lane);
          const int cc = tj * 32 + (lane & 31), ch = 64 * h + cc;
          const float w0 = p.in(16)[layer * 512 + ch], a0 = p.in(18)[layer * 512 + ch], v0 = layer ? p.in(26)[ch] : 0.f;
#pragma unroll
          for (int j = 0; j < 16; ++j) { const int r = ti * 32 + ACC_ROW(j, lane);
              const float xw = w0 + aw[j]; const float wlog = -softplusf_(-xw) - 0.5f;
              LW[r * FS + cc] = -__expf(wlog);
              AS[r * TS + cc] = f2bf(sigmoidf_(a0 + aa[j]));
              if (layer) SV[r * TS + cc] = f2bf(sigmoidf_(v0 + av[j])); } }
        __syncthreads();
        if (tt < 64) { float run = 0.f; for (int r = 0; r < 64; ++r) { run += LW[r * FS + tt]; LW[r * FS + tt] = run; } }
        __syncthreads();
        float vv[16]; float bonus = 0.f; float inv;
        { float kk[16]; const int co = 64 * h + seg * 16; const float* kkp = p.in(19) + layer * 512 + co; float ssq = 0.f;
          ld16_lerp(crow + C_K + co, prow ? prow + C_K + co : nullptr, mu + (C_K - C_RW) + co, kk);
#pragma unroll
          for (int e = 0; e < 16; ++e) { const float x = kk[e] * kkp[e]; ssq += x * x; }
          ssq += shx(ssq, 1); ssq += shx(ssq, 2);
          inv = 1.0f / fmaxf(sqrtf(ssq), 1e-12f); }
        float hA0[8], hB0[8], hA1[8], hB1[8];
#define S4_HALF(HF, HA, HB) do { \
          const int c8 = seg * 16 + (HF) * 8, co8 = 64 * h + c8; \
          float cum[8], cumm[8], av_[8], sv_[8], rr[8], kq[8], v8[8]; \
          _Pragma("unroll") for (int e = 0; e < 8; ++e) { cum[e] = LW[t * FS + c8 + e]; cumm[e] = t > 0 ? LW[(t - 1) * FS + c8 + e] : 0.f; av_[e] = bf2f(AS[t * TS + c8 + e]); sv_[e] = layer ? bf2f(SV[t * TS + c8 + e]) : 0.f; } \
          if (t == 63) { _Pragma("unroll") for (int e = 0; e < 8; ++e) PT[c8 + e] = __expf(cum[e]); } \
          ld8_lerp(crow + C_R + co8, prow ? prow + C_R + co8 : nullptr, mu + (C_R - C_RW) + co8, rr); \
          ld8_lerp(crow + C_K + co8, prow ? prow + C_K + co8 : nullptr, mu + (C_K - C_RW) + co8, kq); \
          ld8_lerp(crow + C_V + co8, prow ? prow + C_V + co8 : nullptr, mu + (C_V - C_RW) + co8, v8); \
          if (layer) { float vf[8]; unpack8(*(const u32x4*)(VF + (size_t)gt * 512 + co8), vf); \
              _Pragma("unroll") for (int e = 0; e < 8; ++e) v8[e] = v8[e] + (vf[e] - v8[e]) * sv_[e]; } \
          else if (PASS == 3) *(u32x4*)(VF + (size_t)gt * 512 + co8) = pack8(v8); \
          const float* kkp8 = p.in(19) + layer * 512 + co8; const float* kap8 = p.in(20) + layer * 512 + co8; const float* rkp8 = p.in(21) + layer * 512 + co8; \
          float oa[8], orr[8]; \
          _Pragma("unroll") for (int e = 0; e < 8; ++e) { const float kkn = kq[e] * kkp8[e] * inv; const float a = av_[e]; const float k2 = kq[e] * (1.0f + (a - 1.0f) * kap8[e]); \
              const float Pt = __expf(cum[e]), Pm = __expf(cumm[e]), iP = __expf(-cum[e]); \
              oa[e] = -kkn * Pm; const float obv = kkn * a * iP; const float okv = k2 * iP; orr[e] = rr[e] * Pt; bonus += rr[e] * k2 * rkp8[e]; \
              vv[(HF) * 8 + e] = v8[e]; VT[(c8 + e) * TS + t] = f2bf(v8[e]); \
              if (PASS == 1) { BT[(c8 + e) * TS + t] = f2bf(obv); HA[e] = obv; HB[e] = okv; } else { HA[e] = oa[e]; HB[e] = okv; oa[e] = obv; } } \
          if (PASS == 1) *(LAS u32x4*)(At + t * TS + c8) = pack8(oa); \
          else { *(LAS u32x4*)(Rn + t * TS + c8) = pack8(orr); *(LAS u32x4*)(Bn + t * TS + c8) = pack8(oa); } \
        } while (0)
        S4_HALF(0, hA0, hB0);
        __builtin_amdgcn_sched_barrier(0);
        S4_HALF(1, hA1, hB1);
#undef S4_HALF
        bonus += shx(bonus, 1); bonus += shx(bonus, 2);
        __syncthreads();
        { const int c0 = seg * 16;
          if (PASS == 1) { *(LAS u32x4*)(Bn + t * TS + c0) = pack8(hA0); *(LAS u32x4*)(Bn + t * TS + c0 + 8) = pack8(hA1);
              *(LAS u32x4*)(Kn + t * TS + c0) = pack8(hB0); *(LAS u32x4*)(Kn + t * TS + c0 + 8) = pack8(hB1);
#pragma unroll
              for (int e = 0; e < 8; ++e) { KT[(c0 + e) * TS + t] = f2bf(hB0[e]); KT[(c0 + 8 + e) * TS + t] = f2bf(hB1[e]); } }
          else { *(LAS u32x4*)(At + t * TS + c0) = pack8(hA0); *(LAS u32x4*)(At + t * TS + c0 + 8) = pack8(hA1);
              *(LAS u32x4*)(Kn + t * TS + c0) = pack8(hB0); *(LAS u32x4*)(Kn + t * TS + c0 + 8) = pack8(hB1); } }
        __syncthreads();
        { const int s = tj * 32 + (lane & 31);
          { f32x16 ak = mma_ll(zero16(), At + ti * 32 * TS, TS, Kn + tj * 32 * TS, TS, 64, lane);
#pragma unroll
            for (int j = 0; j < 16; ++j) { const int r = ti * 32 + ACC_ROW(j, lane); AK[r * TS + s] = (s < r) ? f2bf(ak[j]) : (bf16_t)0; } }
          if (PASS == 3) {
              { f32x16 rb = mma_ll(zero16(), Rn + ti * 32 * TS, TS, Bn + tj * 32 * TS, TS, 64, lane);
#pragma unroll
                for (int j = 0; j < 16; ++j) { const int r = ti * 32 + ACC_ROW(j, lane); ARB[r * TS + s] = (s <= r) ? f2bf(rb[j]) : (bf16_t)0; } }
              { f32x16 rk = mma_ll(zero16(), Rn + ti * 32 * TS, TS, Kn + tj * 32 * TS, TS, 64, lane);
#pragma unroll
                for (int j = 0; j < 16; ++j) { const int r = ti * 32 + ACC_ROW(j, lane); ARK[r * TS + s] = (s <= r) ? f2bf(rk[j]) : (bf16_t)0; } } }
          f32x16 ab = mma_ll(zero16(), At + ti * 32 * TS, TS, Bn + tj * 32 * TS, TS, 64, lane);
          __syncthreads();
#pragma unroll
          for (int j = 0; j < 16; ++j) { const int r = ti * 32 + ACC_ROW(j, lane); AAB[r * FS + s] = ab[j]; } }
        __syncthreads();
        const bf16_t* S0 = SEN + (size_t)item * 4096;
        { f32x16 x = mma_ll(zero16(), AK + ti * 32 * TS, TS, VT + tj * 32 * TS, TS, 64, lane);
          if (PASS == 3) x = mma_lg(x, At + ti * 32 * TS, TS, S0 + (size_t)(tj * 32) * 64, 64, 64, lane);
          __syncthreads();
          const int v = tj * 32 + (lane & 31);
#pragma unroll
          for (int j = 0; j < 16; ++j) { const int r = ti * 32 + ACC_ROW(j, lane); XF[r * FS + v] = x[j]; } }
        __syncthreads();
        { const bool active = (PASS == 1) ? (wq < 2) : (wq == 0);
          if (active) {
              if (PASS == 1 && wq == 0) {
                  for (int r = 1; r < 64; ++r) { float acc = bf2f(At[r * TS + lane]); int s = 0;
                      for (; s + 4 <= r; s += 4) { const f32x4 cf = *(const LAS f32x4*)(AAB + r * FS + s);
                          acc += cf[0] * bf2f(At[s * TS + lane]) + cf[1] * bf2f(At[(s + 1) * TS + lane]) + cf[2] * bf2f(At[(s + 2) * TS + lane]) + cf[3] * bf2f(At[(s + 3) * TS + lane]); }
                      for (; s < r; ++s) acc += AAB[r * FS + s] * bf2f(At[s * TS + lane]);
                      At[r * TS + lane] = f2bf(acc); }
              } else {
                  for (int r = 1; r < 64; ++r) { float acc = XF[r * FS + lane]; int s = 0;
                      for (; s + 4 <= r; s += 4) { const f32x4 cf = *(const LAS f32x4*)(AAB + r * FS + s);
                          acc += cf[0] * XF[s * FS + lane] + cf[1] * XF[(s + 1) * FS + lane] + cf[2] * XF[(s + 2) * FS + lane] + cf[3] * XF[(s + 3) * FS + lane]; }
                      for (; s < r; ++s) acc += AAB[r * FS + s] * XF[s * FS + lane];
                      XF[r * FS + lane] = acc; }
              } }
          __syncthreads();
          float ux[16]; u32x4 w0, w1;
#pragma unroll
          for (int e = 0; e < 16; ++e) ux[e] = XF[t * FS + seg * 16 + e];
          if (PASS == 1) { w0 = *(const LAS u32x4*)(At + t * TS + seg * 16); w1 = *(const LAS u32x4*)(At + t * TS + seg * 16 + 8); }
          __syncthreads();
          if (PASS == 1) { float wx[16]; unpack8(w0, wx); unpack8(w1, wx + 8);
#pragma unroll
              for (int e = 0; e < 16; ++e) { UT0[(seg * 16 + e) * TS + t] = f2bf(wx[e]); UT1[(seg * 16 + e) * TS + t] = f2bf(ux[e]); } }
          else {
#pragma unroll
              for (int e = 0; e < 16; ++e) UT0[(seg * 16 + e) * TS + t] = f2bf(ux[e]); } }
        __syncthreads();
        if (PASS == 1) {
            f32x16 m = mma_ll(zero16(), UT0 + ti * 32 * TS, TS, BT + tj * 32 * TS, TS, 64, lane);
            f32x16 n = mma_ll(zero16(), UT1 + ti * 32 * TS, TS, BT + tj * 32 * TS, TS, 64, lane);
            n = mma_ll(n, VT + ti * 32 * TS, TS, KT + tj * 32 * TS, TS, 64, lane);
            const int k = tj * 32 + (lane & 31); const float pt = PT[k];
            bf16_t* mg = MtG + (size_t)item * 4096; bf16_t* ng = NG + (size_t)item * 4096;
#pragma unroll
            for (int q = 0; q < 4; ++q) { const int r0 = ti * 32 + 8 * q + 4 * (lane >> 5); float mv[4];
#pragma unroll
                for (int e = 0; e < 4; ++e) { mv[e] = (m[4 * q + e] + ((r0 + e) == k ? 1.0f : 0.0f)) * pt; ng[(r0 + e) * 64 + k] = f2bf(n[4 * q + e] * pt); }
                u32x2 w; w.x = pack2(mv[0], mv[1]); w.y = pack2(mv[2], mv[3]); *(u32x2*)(mg + k * 64 + r0) = w; }
        } else {
            f32x16 y = mma_lg(zero16(), Rn + ti * 32 * TS, TS, S0 + (size_t)(tj * 32) * 64, 64, 64, lane);
            y = mma_ll(y, ARB + ti * 32 * TS, TS, UT0 + tj * 32 * TS, TS, 64, lane);
            y = mma_ll(y, ARK + ti * 32 * TS, TS, VT + tj * 32 * TS, TS, 64, lane);
            __syncthreads();
            const int v = tj * 32 + (lane & 31);
#pragma unroll
            for (int j = 0; j < 16; ++j) { const int r = ti * 32 + ACC_ROW(j, lane); XF[r * FS + v] = y[j]; }
            __syncthreads();
            float yv[16]; float sm = 0.f;
#pragma unroll
            for (int e = 0; e < 16; ++e) { yv[e] = XF[t * FS + seg * 16 + e]; sm += yv[e]; }
            sm += shx(sm, 1); sm += shx(sm, 2);
            const float mean = sm * (1.0f / 64.0f); float vs = 0.f;
#pragma unroll
            for (int e = 0; e < 16; ++e) { const float d = yv[e] - mean; vs += d * d; }
            vs += shx(vs, 1); vs += shx(vs, 2);
            const float rs = rsqrtf(vs * (1.0f / 64.0f) + 64e-5f);
            const int co = 64 * h + seg * 16; const float* lg = p.in(22) + layer * 512 + co; const float* lb = p.in(23) + layer * 512 + co;
            float o[16], gg[16];
            ld16_lerp(crow + C_G + co, prow ? prow + C_G + co : nullptr, mu + (C_G - C_RW) + co, gg);
#pragma unroll
            for (int e = 0; e < 16; ++e) { const float yn = (yv[e] - mean) * rs * lg[e] + lb[e] + bonus * vv[e]; o[e] = ((DBG_DBL & 2) ? 2.f : 1.f) * yn * siluf_(gg[e]); }
#if DBG_NORW
#pragma unroll
            for (int e = 0; e < 16; ++e) o[e] = 0.f;
#endif
            st16_g(MIX + (size_t)gt * MIXW + 512 + co, o);
        }
        __syncthreads();
    }
}


#if DBG_SLOWR
__device__ __forceinline__ float xs_lerp(const bf16_t* crow, const bf16_t* prow, int col, float mu) {
    const float c = bf2f(crow[col]); const float q = prow ? bf2f(prow[col]) : 0.f; return c + (q - c) * mu; }
__device__ __forceinline__ void rwkv_slow(const Ctx& p, int layer, LAS unsigned char* lds) {
    if (blockIdx.x >= 8 || ltid() >= 64) return;
    unsigned char* ws = p.wsp(); const bf16_t* PROJ = (const bf16_t*)(ws + OFF_PROJ); bf16_t* MIX = (bf16_t*)(p.outp() + OUT_MIX); bf16_t* VF = (bf16_t*)(ws + OFF_VF);
    const int h = blockIdx.x, c = ltid() & 63, ch = 64 * h + c;
    const float* mu = p.in(14) + layer * 2176; const float* wup = p.in(15) + (size_t)layer * 64 * 512; const float* aup = p.in(17) + (size_t)layer * 64 * 512; const float* vup = p.in(25);
    const float w0 = p.in(16)[layer * 512 + ch], a0 = p.in(18)[layer * 512 + ch], kkw = p.in(19)[layer * 512 + ch], kaw = p.in(20)[layer * 512 + ch], rkw = p.in(21)[layer * 512 + ch];
    const float lng = p.in(22)[layer * 512 + ch], lnb = p.in(23)[layer * 512 + ch]; const float v0 = layer ? p.in(26)[ch] : 0.f;
    const float mu_wd = mu[1536 + c], mu_ad = mu[1600 + c], mu_r = mu[ch], mu_k = mu[512 + ch], mu_v = mu[1024 + ch], mu_g = mu[1664 + ch]; const float mu_vd = (layer && c < 32) ? p.in(24)[c] : 0.f;
    LAS float* T1 = (LAS float*)lds;
    LAS float* VEC = (LAS float*)(lds + 1024);
    LAS float* SL = (LAS float*)(lds + 4096);
#pragma unroll 1
    for (int k = 0; k < 64; ++k) SL[k * 64 + c] = 0.f;
#pragma unroll 1
    for (int t = 0; t < L_; ++t) {
        const bf16_t* crow = PROJ + (size_t)t * PSTR; const bf16_t* prow = t > 0 ? crow - PSTR : nullptr;
        T1[c] = tanhf(xs_lerp(crow, prow, C_WD + c, mu_wd)); T1[64 + c] = xs_lerp(crow, prow, C_AD + c, mu_ad); T1[128 + c] = (layer && c < 32) ? xs_lerp(crow, prow, C_VD + c, mu_vd) : 0.f;
        __builtin_amdgcn_s_waitcnt(0xc07f); __builtin_amdgcn_wave_barrier();
        float wl = 0.f, al = 0.f, vl = 0.f;
#pragma unroll 2
        for (int j = 0; j < 64; ++j) { const float* wr = wup + j * 512; const float* ar = aup + j * 512; wl += T1[j] * wr[ch]; al += T1[64 + j] * ar[ch]; }
        if (layer) {
#pragma unroll 2
            for (int j = 0; j < 32; ++j) { const float* vr = vup + j * 512; vl += T1[128 + j] * vr[ch]; } }
        const float wlog = -softplusf_(-(w0 + wl)) - 0.5f; const float dec = __expf(-__expf(wlog)); const float a = sigmoidf_(a0 + al);
        const float r = xs_lerp(crow, prow, C_R + ch, mu_r), k = xs_lerp(crow, prow, C_K + ch, mu_k), g = xs_lerp(crow, prow, C_G + ch, mu_g); float v = xs_lerp(crow, prow, C_V + ch, mu_v);
        if (layer) { const float vf = bf2f(VF[(size_t)t * 512 + ch]); v = v + (vf - v) * sigmoidf_(v0 + vl); } else VF[(size_t)t * 512 + ch] = f2bf(v);
        float kk = k * kkw; float ss = kk * kk;
#pragma unroll
        for (int o = 32; o > 0; o >>= 1) ss += shx(ss, o);
        kk = kk / fmaxf(sqrtf(ss), 1e-12f);
        const float k2 = k * (1.0f + (a - 1.0f) * kaw);
        __builtin_amdgcn_wave_barrier();
        VEC[c] = r; VEC[64 + c] = dec; VEC[128 + c] = k2; VEC[192 + c] = -kk; VEC[256 + c] = kk * a;
        __builtin_amdgcn_s_waitcnt(0xc07f); __builtin_amdgcn_wave_barrier();
        float sa = 0.f;
#pragma unroll 4
        for (int k = 0; k < 64; ++k) sa += SL[k * 64 + c] * VEC[192 + k];
        float y = 0.f;
#pragma unroll 4
        for (int k = 0; k < 64; ++k) { const float s = SL[k * 64 + c] * VEC[64 + k] + sa * VEC[256 + k] + v * VEC[128 + k]; SL[k * 64 + c] = s; y += s * VEC[k]; }
        float sm = y, bo = r * k2 * rkw;
#pragma unroll
        for (int o = 32; o > 0; o >>= 1) { sm += shx(sm, o); bo += shx(bo, o); }
        const float mean = sm * (1.0f / 64.0f); float vs = (y - mean) * (y - mean);
#pragma unroll
        for (int o = 32; o > 0; o >>= 1) vs += shx(vs, o);
        const float yn = (y - mean) * rsqrtf(vs * (1.0f / 64.0f) + 64e-5f) * lng + lnb + bo * v;
        MIX[(size_t)t * MIXW + 512 + ch] = f2bf(yn * siluf_(g));
        __builtin_amdgcn_wave_barrier();
    }
}
#endif

__device__ __forceinline__ void rwkv_scan(const Ctx& p, int wid, LAS unsigned char* wl  ) {
    const int lane = ltid() & 63; const int h = wid >> 2, v0 = (wid & 3) * 16;
    const bf16_t* MtG = (const bf16_t*)(p.wsp() + OFF_R1); const bf16_t* NG = MtG + (size_t)2048 * 4096;
    bf16_t* SEN = (bf16_t*)(p.outp() + OUT_SEN);
    LAS bf16_t* SL = (LAS bf16_t*)wl;
    f32x4 acc[4];
#pragma unroll
    for (int n = 0; n < 4; ++n) acc[n] = (f32x4){0.f, 0.f, 0.f, 0.f};
#pragma unroll 1
    for (int c = 0; c < 256; ++c) {
        const size_t ib = (size_t)(c * 8 + h) * 4096;
#pragma unroll
        for (int n = 0; n < 4; ++n)
#pragma unroll
            for (int r = 0; r < 4; ++r) SL[((lane >> 4) * 4 + r) * TS + n * 16 + (lane & 15)] = f2bf(acc[n][r]);
        __builtin_amdgcn_s_waitcnt(0xc07f); __builtin_amdgcn_wave_barrier();
        bf16x8 a0 = *(const LAS bf16x8*)(SL + (lane & 15) * TS + 8 * (lane >> 4));
        bf16x8 a1 = *(const LAS bf16x8*)(SL + (lane & 15) * TS + 32 + 8 * (lane >> 4));
        { const int r = lane >> 2, sg = (lane & 3) * 16;
          const u32x4 x0 = *(const LAS u32x4*)(SL + r * TS + sg), x1 = *(const LAS u32x4*)(SL + r * TS + sg + 8);
#if DBG_RWS0
          const u32x4 zz = {0u, 0u, 0u, 0u}; *(u32x4*)(SEN + ib + (v0 + r) * 64 + sg) = zz; *(u32x4*)(SEN + ib + (v0 + r) * 64 + sg + 8) = zz;
#else
          *(u32x4*)(SEN + ib + (v0 + r) * 64 + sg) = x0; *(u32x4*)(SEN + ib + (v0 + r) * 64 + sg + 8) = x1;
#endif
        }
        f32x4 nacc[4];
#pragma unroll
        for (int n = 0; n < 4; ++n) {
#pragma unroll
            for (int r = 0; r < 4; ++r) nacc[n][r] = bf2f(NG[ib + (v0 + (lane >> 4) * 4 + r) * 64 + n * 16 + (lane & 15)]);
            const bf16x8 b0 = *(const bf16x8*)(MtG + ib + (n * 16 + (lane & 15)) * 64 + 8 * (lane >> 4));
            const bf16x8 b1 = *(const bf16x8*)(MtG + ib + (n * 16 + (lane & 15)) * 64 + 32 + 8 * (lane >> 4));
            nacc[n] = __builtin_amdgcn_mfma_f32_16x16x32_bf16(a0, b0, nacc[n], 0, 0, 0);
            nacc[n] = __builtin_amdgcn_mfma_f32_16x16x32_bf16(a1, b1, nacc[n], 0, 0, 0); }
        __builtin_amdgcn_wave_barrier();
#pragma unroll
        for (int n = 0; n < 4; ++n) acc[n] = nacc[n];
    }
}

constexpr int BS_ = 136;
__device__ __forceinline__ void conv16(const bf16_t* PROJ, int gt, int ch0, const float* cw  , const float* cb, float* o) {
#pragma unroll
    for (int e = 0; e < 16; ++e) o[e] = cb[ch0 + e];
#pragma unroll
    for (int j = 0; j < 4; ++j) { const int ts = gt - 3 + j;
        if (ts >= 0) { float x[16]; ld16(PROJ + (size_t)ts * PSTR + C_X + ch0, x);
#pragma unroll
            for (int e = 0; e < 16; ++e) o[e] += cw[j * 1024 + ch0 + e] * x[e]; } }
#pragma unroll
    for (int e = 0; e < 16; ++e) o[e] = siluf_(o[e]);
}
template <int PASS>
__device__ __forceinline__ void mamba_pass(const Ctx& p, int layer, LAS unsigned char* tl, int team_gid, int nteams) {
    unsigned char* ws = p.wsp();
    const int tt0 = ltid() & 255;
    const bf16_t* PROJ = (const bf16_t*)(ws + OFF_PROJ);
    bf16_t* STG = (bf16_t*)(ws + OFF_R1);
    float* GDEC = (float*)(ws + OFF_GDEC); float* SSQ = (float*)(ws + OFF_SSQ);
    bf16_t* MIX = (bf16_t*)(p.outp() + OUT_MIX);
    const float* cw = p.in(27) + layer * 4096; const float* cb = p.in(28) + layer * 1024;
    LAS float* CS = (LAS float*)(tl + 73728);
    LAS float* DTv = (LAS float*)(tl + 73728 + 256);
    LAS bf16_t* XT = (LAS bf16_t*)(tl + 0); LAS bf16_t* BT = (LAS bf16_t*)(tl + 9216);
    LAS bf16_t* Bn = (LAS bf16_t*)(tl + 9216); LAS bf16_t* Cn = (LAS bf16_t*)(tl + 26624); LAS bf16_t* SC = (LAS bf16_t*)(tl + 44032); LAS float* YF = (LAS float*)(tl + 53248);
    for (int item = team_gid; item < 2048; item += nteams) {
        const int c = item >> 3, h = item & 7, gq = h >> 2, t0 = c * 64;
        int tt = tt0; asm volatile("" : "+v"(tt));
        const int wq = __builtin_amdgcn_readfirstlane(tt >> 6), lane = tt & 63, ti = wq >> 1, tj = wq & 1;
        const int t = tt >> 2, seg = tt & 3, gt = t0 + t;
        if (tt < 64) { const float dtr = bf2f(PROJ[(size_t)(t0 + tt) * PSTR + C_DT + h]) + p.in(29)[layer * 8 + h];
            const float dt = softplusf_(dtr); float da = -dt * __expf(p.in(30)[layer * 8 + h]);
#pragma unroll
            for (int o = 1; o < 64; o <<= 1) { const float n = shup(da, o); if (tt >= o) da += n; }
            CS[tt] = da; DTv[tt] = dt; }
        __syncthreads();
        float xv[16];
        { const float cs63 = CS[63], cst = CS[t], dt = DTv[t];
          conv16(PROJ, gt, 64 * h + seg * 16, cw, cb, xv);
          const float f = (PASS == 1) ? dt * __expf(cs63 - cst) : dt;
#pragma unroll
          for (int e = 0; e < 16; ++e) XT[(seg * 16 + e) * TS + t] = f2bf(xv[e] * f);
#pragma unroll
          for (int hh = 0; hh < 2; ++hh) { const int n0 = hh * 64 + seg * 16; float bv[16];
              conv16(PROJ, gt, 512 + 128 * gq + n0, cw, cb, bv);
              if (PASS == 1) {
#pragma unroll
                  for (int e = 0; e < 16; ++e) BT[(n0 + e) * TS + t] = f2bf(bv[e]);
              } else { st16_lds(Bn + t * BS_ + n0, bv); conv16(PROJ, gt, 768 + 128 * gq + n0, cw, cb, bv); st16_lds(Cn + t * BS_ + n0, bv); } }
          if (PASS == 1 && tt == 0) GDEC[item] = __expf(cs63); }
        __syncthreads();
        if (PASS == 1) {
            bf16_t* sg = STG + (size_t)item * 8192;
#pragma unroll
            for (int nn = 0; nn < 2; ++nn) { const int nt = tj * 2 + nn;
                f32x16 a = mma_ll(zero16(), XT + ti * 32 * TS, TS, BT + nt * 32 * TS, TS, 64, lane);
                const int n = nt * 32 + (lane & 31);
#pragma unroll
                for (int j = 0; j < 16; ++j) { const int r = ti * 32 + ACC_ROW(j, lane); sg[r * 128 + n] = f2bf(a[j]); } }
        } else {
            { f32x16 sc = mma_ll(zero16(), Cn + ti * 32 * BS_, BS_, Bn + tj * 32 * BS_, BS_, 128, lane);
              const int s = tj * 32 + (lane & 31); const float css = CS[s];
#pragma unroll
              for (int j = 0; j < 16; ++j) { const int r = ti * 32 + ACC_ROW(j, lane); SC[r * TS + s] = (s <= r) ? f2bf(sc[j] * __expf(CS[r] - css)) : (bf16_t)0; } }
            __syncthreads();
            { f32x16 yd = mma_ll(zero16(), SC + ti * 32 * TS, TS, XT + tj * 32 * TS, TS, 64, lane);
              f32x16 yo = mma_lg(zero16(), Cn + ti * 32 * BS_, BS_, STG + (size_t)item * 8192 + (size_t)(tj * 32) * 128, 128, 128, lane);
              const int pp = tj * 32 + (lane & 31);
#pragma unroll
              for (int j = 0; j < 16; ++j) { const int r = ti * 32 + ACC_ROW(j, lane); YF[r * FS + pp] = yd[j] + __expf(CS[r]) * yo[j]; } }
            __syncthreads();
            { const float dsk = p.in(31)[layer * 8 + h]; float z[16], o[16]; float ss = 0.f;
              ld16(PROJ + (size_t)gt * PSTR + C_Z + 64 * h + seg * 16, z);
#pragma unroll
              for (int e = 0; e < 16; ++e) { const float y = YF[t * FS + seg * 16 + e] + xv[e] * dsk; o[e] = (DBG_ZERO & 4) ? 0.f : y * siluf_(z[e]); ss += o[e] * o[e]; }
              ss += shx(ss, 1); ss += shx(ss, 2);
              if (seg == 0) SSQ[gt * 8 + h] = ss;
              st16_g(MIX + (size_t)gt * MIXW + 1024 + 64 * h + seg * 16, o); }
        }
        __syncthreads();
    }
}
__device__ __forceinline__ void mamba_scan(const Ctx& p, int gtid) {
    bf16_t* STG = (bf16_t*)(p.wsp() + OFF_R1); const float* GDEC = (const float*)(p.wsp() + OFF_GDEC);
    const int h = gtid >> 13, pn = gtid & 8191; float st = 0.f;
#pragma unroll 8
    for (int c = 0; c < 256; ++c) { const size_t o = (size_t)(c * 8 + h) * 8192 + pn; const float s = bf2f(STG[o]); STG[o] = f2bf(st); st = st * GDEC[c * 8 + h] + s; }
}


#if DBG_SLOWM
constexpr size_t OFF_DBGDT = WS_END + 4096;
__device__ __forceinline__ void mamba_slow_prep(const Ctx& p, int layer) {
    unsigned char* ws = p.wsp(); const bf16_t* PROJ = (const bf16_t*)(ws + OFF_PROJ); bf16_t* XBC = (bf16_t*)(ws + OFF_R1); float* DT = (float*)(ws + OFF_DBGDT);
    const float* cw = p.in(27) + layer * 4096; const float* cb = p.in(28) + layer * 1024;
    for (int i = blockIdx.x * 512 + ltid(); i < L_ * 64; i += gridDim.x * 512) { const int t = i >> 6, ch0 = (i & 63) * 16; float o[16];
        conv16(PROJ, t, ch0, cw, cb, o); st16_g(XBC + (size_t)t * 1024 + ch0, o);
        if ((i & 63) < 8) { const int h = i & 63; DT[t * 8 + h] = softplusf_(bf2f(PROJ[(size_t)t * PSTR + C_DT + h]) + p.in(29)[layer * 8 + h]); } }
}
__device__ __forceinline__ void mamba_slow_seq(const Ctx& p, int layer) {
    if (blockIdx.x >= 8 || ltid() >= 64) return;
    unsigned char* ws = p.wsp(); const bf16_t* PROJ = (const bf16_t*)(ws + OFF_PROJ); const bf16_t* XBC = (const bf16_t*)(ws + OFF_R1); const float* DT = (const float*)(ws + OFF_DBGDT);
    bf16_t* MIX = (bf16_t*)(p.outp() + OUT_MIX); float* SSQ = (float*)(ws + OFF_SSQ);
    const int h = blockIdx.x, pp = ltid() & 63, gq = h >> 2;
    const float A = -__expf(p.in(30)[layer * 8 + h]), dsk = p.in(31)[layer * 8 + h];
    float st[128];
#pragma unroll
    for (int n = 0; n < 128; ++n) st[n] = 0.f;
#pragma unroll 1
    for (int t = 0; t < L_; ++t) {
        const float dt = DT[t * 8 + h]; const float dec = __expf(dt * A);
        const float x = bf2f(XBC[(size_t)t * 1024 + 64 * h + pp]); const float xdt = x * dt; float y = 0.f;
        const bf16_t* Bp = XBC + (size_t)t * 1024 + 512 + 128 * gq; const bf16_t* Cp = XBC + (size_t)t * 1024 + 768 + 128 * gq;
#pragma unroll
        for (int n8 = 0; n8 < 128; n8 += 8) { float bv[8], cv[8]; unpack8(*(const u32x4*)(Bp + n8), bv); unpack8(*(const u32x4*)(Cp + n8), cv);
#pragma unroll
            for (int e = 0; e < 8; ++e) { st[n8 + e] = st[n8 + e] * dec + xdt * bv[e]; y += cv[e] * st[n8 + e]; } }
        const float z = bf2f(PROJ[(size_t)t * PSTR + C_Z + 64 * h + pp]);
        const float yg = (y + x * dsk) * siluf_(z); float ss = yg * yg;
#pragma unroll
        for (int o = 32; o > 0; o >>= 1) ss += shx(ss, o);
        if (pp == 0) SSQ[t * 8 + h] = ss;
        MIX[(size_t)t * MIXW + 1024 + 64 * h + pp] = f2bf(yg);
    }
}
#endif


#if DBG_SLOWS
__device__ __forceinline__ void s5_slow(const Ctx& p, int layer) {
    if (blockIdx.x >= 32 || ltid() >= 64) return;
    unsigned char* ws = p.wsp(); const bf16_t* PROJ = (const bf16_t*)(ws + OFF_PROJ); bf16_t* YB = (bf16_t*)(p.outp() + OUT_SEN);
    const int g = blockIdx.x, pp = ltid() & 63, gp = g * 64 + pp;
    const float dt = expf(p.in(4)[layer * 32 + g]); const float ar = p.in(5)[layer * 2048 + gp], ai = p.in(6)[layer * 2048 + gp];
    const float mag = expf(dt * ar); const float abr = mag * cosf(dt * ai), abi = mag * sinf(dt * ai);
    const float den = ar * ar + ai * ai; const float fre = ((abr - 1.0f) * ar + abi * ai) / den, fim = (abi * ar - (abr - 1.0f) * ai) / den;
    float bre[16], bim[16], cre[16], cim[16];
#pragma unroll
    for (int c = 0; c < 16; ++c) { const float br = p.in(7)[(size_t)layer * 32768 + gp * 16 + c], bi = p.in(8)[(size_t)layer * 32768 + gp * 16 + c];
        bre[c] = fre * br - fim * bi; bim[c] = fre * bi + fim * br;
        cre[c] = p.in(9)[(size_t)layer * 32768 + g * 1024 + c * 64 + pp]; cim[c] = p.in(10)[(size_t)layer * 32768 + g * 1024 + c * 64 + pp]; }
    const float dsk = pp < 16 ? p.in(11)[layer * 512 + g * 16 + pp] : 0.f;
    float sr = 0.f, si = 0.f;
#pragma unroll 1
    for (int t = 0; t < L_; ++t) {
        float u[16]; ld16(PROJ + (size_t)t * PSTR + C_S5U + 16 * g, u);
        float br = 0.f, bi = 0.f;
#pragma unroll
        for (int c = 0; c < 16; ++c) { br += u[c] * bre[c]; bi += u[c] * bim[c]; }
        const float nr = abr * sr - abi * si + br, ni = abr * si + abi * sr + bi; sr = nr; si = ni;
        float mine = 0.f;
#pragma unroll
        for (int c = 0; c < 16; ++c) { float v = cre[c] * sr - cim[c] * si;
#pragma unroll
            for (int o = 32; o > 0; o >>= 1) v += shx(v, o);
            if (pp == c) mine = v + dsk * u[c]; }
        if (pp < 16) { const float ge = 0.5f * mine * (1.0f + tanhf(0.7978845608f * (mine + 0.044715f * mine * mine * mine))); YB[(size_t)t * 512 + 16 * g + pp] = f2bf(ge); }
    }
}
#endif

template <int PASS>
__device__ __forceinline__ void s5_pass(const Ctx& p, int layer, LAS unsigned char* tl, int team_gid, int nteams) {
    unsigned char* ws = p.wsp();
    const int tt0 = ltid() & 255;
    const bf16_t* PROJ = (const bf16_t*)(ws + OFF_PROJ);
    const bf16_t* BB = (const bf16_t*)(ws + OFF_BB); const bf16_t* CC = (const bf16_t*)(ws + OFF_CC);
    const float2* AB = (const float2*)(ws + OFF_ABAR); float2* S5E = (float2*)(ws + OFF_S5E);
    bf16_t* YB = (bf16_t*)(p.outp() + OUT_SEN);
    for (int item = team_gid; item < 2048; item += nteams) {
        int tt = tt0; asm volatile("" : "+v"(tt));
        const int wq = __builtin_amdgcn_readfirstlane(tt >> 6), lane = tt & 63;
        LAS bf16_t* BU = (LAS bf16_t*)(tl + wq * 17408);
        const int c = item >> 3, g = (item & 7) * 4 + wq, t0 = c * 64;
#pragma unroll
        for (int tr = 0; tr < 2; ++tr) {
            const bf16x8 a = *(const bf16x8*)(PROJ + (size_t)(t0 + tr * 32 + (lane & 31)) * PSTR + C_S5U + 16 * g + 8 * (lane >> 5));
#pragma unroll
            for (int qt = 0; qt < 4; ++qt) {
                const bf16x8 b = *(const bf16x8*)(BB + (size_t)(g * 128 + qt * 32 + (lane & 31)) * 16 + 8 * (lane >> 5));
                f32x16 r = __builtin_amdgcn_mfma_f32_32x32x16_bf16(a, b, zero16(), 0, 0, 0);
#pragma unroll
                for (int j = 0; j < 16; ++j) BU[(tr * 32 + ACC_ROW(j, lane)) * BS_ + qt * 32 + (lane & 31)] = f2bf(r[j]); } }
        __syncthreads();
        { const float2 ab = AB[g * 64 + lane]; float sr = 0.f, si = 0.f;
          if (PASS == 3) { const float2 s0 = S5E[(size_t)(c * 32 + g) * 64 + lane]; sr = s0.x; si = s0.y; }
          for (int t = 0; t < 64; ++t) { const float br = bf2f(BU[t * BS_ + lane]), bi = bf2f(BU[t * BS_ + 64 + lane]);
              const float nr = ab.x * sr - ab.y * si + br, ni = ab.x * si + ab.y * sr + bi; sr = nr; si = ni;
              if (PASS == 3) { BU[t * BS_ + lane] = f2bf(sr); BU[t * BS_ + 64 + lane] = f2bf(si); } }
          if (PASS == 1) S5E[(size_t)(c * 32 + g) * 64 + lane] = make_float2(sr, si); }
        __syncthreads();
        if (PASS == 3) {
            const int cc = lane & 31;
#pragma unroll
            for (int tr = 0; tr < 2; ++tr) {
                f32x16 y = mma_lg(zero16(), BU + tr * 32 * BS_, BS_, CC + (size_t)(g * 32) * 128, 128, 128, lane);
                if (cc < 16) { const float dsk = p.in(11)[layer * 512 + g * 16 + cc];
#pragma unroll
                    for (int j = 0; j < 16; ++j) { const int gt = t0 + tr * 32 + ACC_ROW(j, lane);
                        const float u = bf2f(PROJ[(size_t)gt * PSTR + C_S5U + 16 * g + cc]);
                        const float v = y[j] + dsk * u;
                        const float ge = 0.5f * v * (1.0f + tanhf(0.7978845608f * (v + 0.044715f * v * v * v)));
                        YB[(size_t)gt * 512 + 16 * g + cc] = f2bf(ge); } } }
        }
        __syncthreads();
    }
}
__device__ __forceinline__ void s5_scan(const Ctx& p, int gtid) {
    float2* S5E = (float2*)(p.wsp() + OFF_S5E); const float2 a = ((const float2*)(p.wsp() + OFF_AB64))[gtid];
    float sr = 0.f, si = 0.f;
#pragma unroll 8
    for (int c = 0; c < 256; ++c) { const size_t o = (size_t)c * 2048 + gtid; const float2 e = S5E[o]; S5E[o] = make_float2(sr, si);
        const float nr = a.x * sr - a.y * si + e.x, ni = a.x * si + a.y * sr + e.y; sr = nr; si = ni; }
}

static_assert(WS_END <= (size_t)256 * 1024 * 1024, "workspace overflow");
__global__ void __launch_bounds__(512, 2) mega_fwd(Params pa) {
    extern __shared__ __attribute__((aligned(16))) unsigned char smem[];
    LAS unsigned char* lds = (LAS unsigned char*)smem;
    cg::grid_group grid = cg::this_grid();
    const int team = __builtin_amdgcn_readfirstlane(ltid() >> 8), team_gid = blockIdx.x * 2 + team, nteams = gridDim.x * 2;
    LAS unsigned char* tl = lds + team * TEAM_LDS;
    if (ltid() == 0) { LAS unsigned long long* tw = (LAS unsigned long long*)(lds + PTAB_OFF);
#pragma unroll
        for (int i = 0; i < 35; ++i) tw[i] = (unsigned long long)pa.in[i]; }
    __syncthreads();
    Ctx p; p.tab = (LAS const unsigned*)(lds + PTAB_OFF); p.out = pa.out; p.ws = pa.ws;
    unsigned char* ws = p.ws;
    bf16_t* PROJ = (bf16_t*)(ws + OFF_PROJ); bf16_t* MIX = (bf16_t*)((unsigned char*)p.out + OUT_MIX);
    unsigned* gbar = (unsigned*)(ws + OFF_BAR); unsigned seam = 0;
    grid.sync();
    for (int layer = 0; layer < (DBG_PROBE ? 1 : 2); ++layer) {
#if (!defined(ONLY) || ONLY==0) && ((DBG_MASK >> 0) & 1)
        phase_prep(p, layer, lds);
#endif
        grid.sync();
#if (!defined(ONLY) || ONLY==1) && ((DBG_MASK >> 1) & 1)
        { pg8::Gemm g{(const bf16_t*)(ws + OFF_R1), (const bf16_t*)(ws + OFF_WIN), L_, NPAD, 1024}; pg8::StaticOrder S; S.init(L_, NPAD, (int)gridDim.x, (int)blockIdx.x);
          EpiProj E{PROJ}; pg8::gemm_phase<EpiProj, pg8::StaticOrder, false>(lds, g, S, E, nullptr); }
#endif
        grid.sync();
#if (!defined(ONLY) || ONLY==2) && ((DBG_MASK >> 2) & 1)
#if !DBG_SLOWR
        rwkv_pass<1>(p, layer, tl, team_gid, nteams);
#endif
#endif
#if (!defined(ONLY) || ONLY==3) && ((DBG_MASK >> 3) & 1)
        s5_pass<1>(p, layer, tl, team_gid, nteams);
#endif
        grid.sync();
#if (!defined(ONLY) || ONLY==4) && ((DBG_MASK >> 4) & 1)
        if (blockIdx.x < 32) { if (!DBG_SLOWR && ltid() < 64) rwkv_scan(p, blockIdx.x, lds); }
        else if (blockIdx.x < 36) s5_scan(p, (blockIdx.x - 32) * 512 + ltid());
#endif
        grid.sync();
#if (!defined(ONLY) || ONLY==5) && ((DBG_MASK >> 5) & 1)
#if DBG_SLOWR
        rwkv_slow(p, layer, lds);
#else
        rwkv_pass<3>(p, layer, tl, team_gid, nteams);
#endif
#endif
        grid.sync();
#if (!defined(ONLY) || ONLY==6) && ((DBG_MASK >> 6) & 1)
#if DBG_SLOWM
        mamba_slow_prep(p, layer);
#else
        mamba_pass<1>(p, layer, tl, team_gid, nteams);
#endif
#endif
#if (!defined(ONLY) || ONLY==7) && ((DBG_MASK >> 7) & 1)
#if DBG_SLOWS
        s5_slow(p, layer);
#else
        s5_pass<3>(p, layer, tl, team_gid, nteams);
#endif
#endif
        grid.sync();
#if (!defined(ONLY) || ONLY==8) && ((DBG_MASK >> 8) & 1)
        if (blockIdx.x < 128) { if (!DBG_SLOWM) mamba_scan(p, blockIdx.x * 512 + ltid()); }
        else { pg8::Gemm g{(const bf16_t*)((unsigned char*)p.out + OUT_SEN), (const bf16_t*)(ws + OFF_WGLU), L_, 512, 512}; pg8::StaticOrder S; S.init(L_, 512, 128, (int)blockIdx.x - 128);
          EpiGlu E{MIX, (const bf16_t*)((unsigned char*)p.out + OUT_SEN), PROJ, p.in(13) + layer * 512}; pg8::gemm_phase<EpiGlu, pg8::StaticOrder, false>(lds, g, S, E, nullptr); }
#endif
        grid.sync();
#if (!defined(ONLY) || ONLY==9) && ((DBG_MASK >> 9) & 1)
#if DBG_SLOWM
        mamba_slow_seq(p, layer);
#else
        mamba_pass<3>(p, layer, tl, team_gid, nteams);
#endif
#endif
        grid.sync();
#if (!defined(ONLY) || ONLY==10) && ((DBG_MASK >> 10) & 1)
        m2_normalize(p, 0, (int)gridDim.x);
#endif
        grid.sync();
#if (!defined(ONLY) || ONLY==11) && ((DBG_MASK >> 11) & 1)
        { pg8::Gemm g{MIX, (const bf16_t*)(ws + OFF_WOUT), L_, 1024, 1536}; pg8::StaticOrder S; S.init(L_, 1024, (int)gridDim.x, (int)blockIdx.x);
          if (layer == 0) { EpiD0 E{(bf16_t*)(ws + OFF_D0)}; pg8::gemm_phase<EpiD0, pg8::StaticOrder, false>(lds, g, S, E, nullptr); }
          else { EpiH2 E{(float*)(ws + OFF_PROJ)}; pg8::gemm_phase<EpiH2, pg8::StaticOrder, false>(lds, g, S, E, nullptr); } }
#endif
        grid.sync();
    }
#if DBG_PROBE
    phase_probe(p);
    grid.sync();
#endif
    phase_final(p);
}

extern "C" void kernel_launch(void* const* d_in, const int* in_sizes, int n_in, void* d_out, int out_size, void* d_ws, size_t ws_size, hipStream_t stream) {
    static int grid_blocks = 0;
    if (!grid_blocks) {
        int dev = 0, cus = 0, per_cu = 0;
        hipGetDevice(&dev);
        hipDeviceGetAttribute(&cus, hipDeviceAttributeMultiprocessorCount, dev);
        hipFuncSetAttribute((const void*)mega_fwd, hipFuncAttributeMaxDynamicSharedMemorySize, LDS_BYTES);
        hipOccupancyMaxActiveBlocksPerMultiprocessor(&per_cu, (const void*)mega_fwd, 512, LDS_BYTES);
        int cap = cus * per_cu;
        grid_blocks = cap >= 256 ? 256 : -1;
        if (grid_blocks < 0) fprintf(stderr, "kernel_launch: resident capacity %d x %d < 256 workgroups\n", cus, per_cu);
        if (n_in != 35 || ws_size < WS_END + (size_t)(1 << 20)) { fprintf(stderr, "kernel_launch: unexpected n_in %d / ws %zu\n", n_in, ws_size); grid_blocks = -1; }
    }
    if (grid_blocks < 0) return;
    (void)hipMemsetAsync((unsigned char*)d_ws + OFF_BAR, 0, 256, stream);
    Params p{};
    for (int i = 0; i < 35; ++i) p.in[i] = (const float*)d_in[i];
    p.out = (float*)d_out; p.ws = (unsigned char*)d_ws;
    void* args[] = {&p};
    hipError_t e = hipLaunchCooperativeKernel((const void*)mega_fwd, dim3(grid_blocks), dim3(512), args, LDS_BYTES, stream);
    if (e != hipSuccess) fprintf(stderr, "cooperative launch failed: %s\n", hipGetErrorString(e));
}
```

```cpp
#include <hip/hip_runtime.h>
#include <hip/hip_cooperative_groups.h>
#include <cstdio>
namespace cg = cooperative_groups;
namespace pg8 {
#define PG8_LAS __attribute__((address_space(3)))
typedef unsigned short bf16_t;
typedef short bf16x8 __attribute__((ext_vector_type(8)));
typedef float f32x4 __attribute__((ext_vector_type(4)));
typedef unsigned u32x4 __attribute__((ext_vector_type(4)));
constexpr int BM = 256, BK = 64, HALF = 128, HTB = HALF * BK * 2  , STAGE_BYTES = 8 * HTB, NXCD = 8, WGM = 8;

__host__ __device__ __forceinline__ int lds_byte(int r, int c) { const int st = (r >> 4) * 2 + (c >> 5), rr = r & 15, cc = c & 31, ob = rr * 64 + cc * 2; return st * 1024 + (ob ^ (((ob >> 9) & 1) << 5)); }
__host__ __device__ __forceinline__ void stage_rc(int b, int& R, int& C) { const int st = b / 1024, sb = b % 1024, swz = sb ^ (((sb >> 9) & 1) << 5); R = (st >> 1) * 16 + swz / 64; C = (st & 1) * 32 + (swz % 64) / 2; }
__host__ __device__ __forceinline__ int perm32(int rho) { const int n = rho >> 4, i = rho & 15; return 8 * (i >> 2) + 4 * n + (i & 3); }

struct Unit { int pm, pn; };
struct Gemm { const bf16_t* A; const bf16_t* Bt; int M, N, K; int lda; };

struct StaticOrder {
    int nM, nN, nwg, G, c;
    __host__ __device__ void init(int M, int N, int G_, int c_) { nM = M / BM; nN = N / BM; nwg = nM * nN; G = G_; c = c_; }
    __host__ __device__ bool next(int i, Unit& u) const {
        const long L = (long)i * G + c; if (L >= nwg) return false;
        int wgid = (int)L; { const int q = nwg / NXCD, r = nwg % NXCD, xcd = wgid % NXCD, off = wgid / NXCD; wgid = (xcd < r ? xcd * (q + 1) : r * (q + 1) + (xcd - r) * q) + off; }
        const int nig = WGM * nN, gid = wgid / nig, fm = gid * WGM, gsz = (nM - fm) < WGM ? (nM - fm) : WGM;
        u.pm = fm + ((wgid % nig) % gsz); u.pn = (wgid % nig) / gsz; return true;
    }
    __device__ __forceinline__ void a_ready(const Unit&) const {}
    __device__ __forceinline__ void done(const Unit&) const {}
};
__device__ __forceinline__ unsigned cvt_pk_bf16(float lo, float hi) { unsigned r; asm volatile("v_cvt_pk_bf16_f32 %0, %1, %2" : "=v"(r) : "v"(lo), "v"(hi)); return r; }
template <class Epi, class Sched, bool STAMP = false>
__device__ __forceinline__ void gemm_phase(PG8_LAS unsigned char* lds, const Gemm g, const Sched& S, const Epi& E, unsigned long long* stamps) {
    int tid_raw = threadIdx.x; asm volatile("" : "+v"(tid_raw)); const int tid = tid_raw, wid = __builtin_amdgcn_readfirstlane(tid >> 6), lane = tid & 63, wr = wid >> 2, wc = wid & 3, fr = lane & 15, fq = lane >> 4;
    const int K = g.K, nt = K / BK;
    int ts_lo = 0, ts_hi = 0, nts = 0; const unsigned long long rt_entry = STAMP ? (unsigned long long)0ull : 0ull;
#define PG8_STAMP() do { if (STAMP && wid == 0 && nts < 64) { const unsigned long long _c = (unsigned long long)clock64(); \
        ts_lo = (lane == nts) ? (int)(unsigned)_c : ts_lo; ts_hi = (lane == nts) ? (int)(unsigned)(_c >> 32) : ts_hi; ++nts; } } while (0)
    PG8_STAMP();
    unsigned voffA[2], voffB[2];
#pragma unroll
    for (int i = 0; i < 2; ++i) { int R, C; stage_rc(tid * 16 + i * 8192, R, C); const int Rb = Epi::PERM ? ((R & ~31) + perm32(R & 31)) : R;
        voffA[i] = (unsigned)(R * g.lda + C) * 2u; voffB[i] = (unsigned)(Rb * K + C) * 2u; }
    const size_t kstep = (size_t)(BK * 2);
    const size_t hstep = (size_t)HALF * K * 2, hstepA = (size_t)HALF * g.lda * 2;
    const size_t tstep = 2 * hstep, tstepA = 2 * hstepA;
    const unsigned ldsw = (unsigned)wid * 1024u;
    const int aoff = lds_byte(wr * 64 + fr, fq * 8), boff = lds_byte(wc * 32 + fr, fq * 8);
#define PG8_SA(b, h) (((b) * 2 + (h)) * HTB)
#define PG8_SB(b, h) ((4 + (b) * 2 + (h)) * HTB)
#define PG8_STAGE(bufoff, gbase, voff) do { _Pragma("unroll") for (int _i = 0; _i < 2; ++_i) \
        __builtin_amdgcn_global_load_lds((const unsigned*)((const char*)(gbase) + (voff)[_i]), (PG8_LAS unsigned*)(lds + (bufoff) + ldsw + _i * 8192), 16, 0, 0); } while (0)
#define PG8_LDA(dst, b, h) do { _Pragma("unroll") for (int m = 0; m < 4; ++m) _Pragma("unroll") for (int k = 0; k < 2; ++k) dst[m][k] = *(const PG8_LAS bf16x8*)(lds + PG8_SA(b, h) + aoff + m * 2048 + k * 1024); } while (0)
#define PG8_LDB(dst, b, h) do { _Pragma("unroll") for (int n = 0; n < 2; ++n) _Pragma("unroll") for (int k = 0; k < 2; ++k) dst[n][k] = *(const PG8_LAS bf16x8*)(lds + PG8_SB(b, h) + boff + n * 2048 + k * 1024); } while (0)
#define PG8_MMA(ai, bj, At, Bt) do { __builtin_amdgcn_s_setprio(1); _Pragma("unroll") for (int m = 0; m < 4; ++m) _Pragma("unroll") for (int n = 0; n < 2; ++n) _Pragma("unroll") for (int k = 0; k < 2; ++k) \
        acc[ai][bj][m][n] = __builtin_amdgcn_mfma_f32_16x16x32_bf16(Bt[n][k], At[m][k], acc[ai][bj][m][n], 0, 0, 0); __builtin_amdgcn_s_setprio(0); } while (0)
#define PG8_WAIT_V(n) asm volatile("s_waitcnt vmcnt(" #n ")" ::: "memory")
#define PG8_WAIT_L(n) asm volatile("s_waitcnt lgkmcnt(" #n ")" ::: "memory")
#define PG8_BAR __builtin_amdgcn_s_barrier()
#define PG8_SCHED __builtin_amdgcn_sched_barrier(0)
    Unit cur, nxt; int ui = 0;
    if (!S.next(0, cur)) return;
    f32x4 acc[2][2][4][2];
#pragma unroll
    for (int a = 0; a < 2; ++a)
#pragma unroll
        for (int b = 0; b < 2; ++b)
#pragma unroll
            for (int m = 0; m < 4; ++m)
#pragma unroll
                for (int n = 0; n < 2; ++n) acc[a][b][m][n] = (f32x4){0.f, 0.f, 0.f, 0.f};
    bf16x8 At[4][2], B0[2][2], B1[2][2];
    const char* cA = (const char*)g.A + (size_t)cur.pm * tstepA; const char* cB = (const char*)g.Bt + (size_t)cur.pn * tstep;
    S.a_ready(cur);
    PG8_STAGE(PG8_SB(0, 0), cB, voffB); PG8_STAGE(PG8_SA(0, 0), cA, voffA); PG8_STAGE(PG8_SB(0, 1), cB + hstep, voffB); PG8_STAGE(PG8_SA(0, 1), cA + hstepA, voffA);
    if (wr == 1) PG8_BAR;
    PG8_WAIT_V(4); PG8_BAR;
    PG8_STAGE(PG8_SB(1, 0), cB + kstep, voffB); PG8_STAGE(PG8_SA(1, 0), cA + kstep, voffA); PG8_STAGE(PG8_SB(1, 1), cB + hstep + kstep, voffB);
    PG8_WAIT_V(6); PG8_BAR;
    PG8_STAMP();
    for (;;) {
        const bool has_next = S.next(ui + 1, nxt);
        const char* nA = has_next ? (const char*)g.A + (size_t)nxt.pm * tstepA : cA; const char* nB = has_next ? (const char*)g.Bt + (size_t)nxt.pn * tstep : cB;
        for (int t = 0; t < nt; t += 2) {
            const bool last = (t == nt - 2);
            const char* a1 = cA + (size_t)(t + 1) * kstep;
            const char* a2 = last ? nA : cA + (size_t)(t + 2) * kstep; const char* b2 = last ? nB : cB + (size_t)(t + 2) * kstep;
            const char* a3 = a2 + kstep; const char* b3 = b2 + kstep;
            if (last && has_next) S.a_ready(nxt);
            PG8_LDB(B0, 0, 0); PG8_SCHED; PG8_LDA(At, 0, 0); PG8_STAGE(PG8_SA(1, 1), a1 + hstepA, voffA);
            PG8_WAIT_L(8); PG8_BAR; PG8_WAIT_L(0); PG8_MMA(0, 0, At, B0); PG8_BAR; PG8_SCHED;
            PG8_LDB(B1, 0, 1); PG8_STAGE(PG8_SB(0, 0), b2, voffB);
            PG8_BAR; PG8_WAIT_L(0); PG8_MMA(0, 1, At, B1); PG8_BAR;
            PG8_LDA(At, 0, 1); PG8_STAGE(PG8_SA(0, 0), a2, voffA);
            PG8_BAR; PG8_WAIT_L(0); PG8_MMA(1, 0, At, B0); PG8_BAR; PG8_SCHED;
            PG8_STAGE(PG8_SB(0, 1), b2 + hstep, voffB);
            PG8_WAIT_V(6); PG8_BAR; PG8_MMA(1, 1, At, B1); PG8_BAR;
            PG8_LDB(B0, 1, 0); PG8_SCHED; PG8_LDA(At, 1, 0); PG8_STAGE(PG8_SA(0, 1), a2 + hstepA, voffA);
            PG8_WAIT_L(8); PG8_BAR; PG8_WAIT_L(0); PG8_MMA(0, 0, At, B0); PG8_BAR; PG8_SCHED;
            PG8_LDB(B1, 1, 1); PG8_STAGE(PG8_SB(1, 0), b3, voffB);
            PG8_BAR; PG8_WAIT_L(0); PG8_MMA(0, 1, At, B1); PG8_BAR;
            PG8_LDA(At, 1, 1); PG8_STAGE(PG8_SA(1, 0), a3, voffA);
            PG8_BAR; PG8_WAIT_L(0); PG8_MMA(1, 0, At, B0); PG8_BAR; PG8_SCHED;
            PG8_STAGE(PG8_SB(1, 1), b3 + hstep, voffB);
            PG8_WAIT_V(6); PG8_BAR; PG8_MMA(1, 1, At, B1); PG8_BAR;
        }
        PG8_STAMP();
        if constexpr (!Epi::AFTER_DRAIN) { E(acc, cur, wr, wc, fr, fq); S.done(cur); }
        PG8_STAMP();
        if (!has_next) break;
#pragma unroll
        for (int a = 0; a < 2; ++a)
#pragma unroll
            for (int b = 0; b < 2; ++b)
#pragma unroll
                for (int m = 0; m < 4; ++m)
#pragma unroll
                    for (int n = 0; n < 2; ++n) acc[a][b][m][n] = (f32x4){0.f, 0.f, 0.f, 0.f};
        cur = nxt; cA = nA; cB = nB; ++ui;
    }
    PG8_WAIT_V(0);
    if (wr == 0) PG8_BAR;
    PG8_BAR;
    if constexpr (Epi::AFTER_DRAIN) { E.fused(acc, cur, wr, wc, fr, fq, lds, wid, lane); S.done(cur); }
    PG8_STAMP();
    if (STAMP && wid == 0) { stamps[lane] = lane < nts ? (((unsigned long long)(unsigned)ts_hi << 32) | (unsigned)ts_lo) : 0ull;
        if (lane == 62) stamps[62] = rt_entry; if (lane == 63) stamps[63] = (unsigned long long)0ull; }
#undef PG8_STAMP
#undef PG8_SA
#undef PG8_SB
#undef PG8_STAGE
#undef PG8_LDA
#undef PG8_LDB
#undef PG8_MMA
#undef PG8_WAIT_V
#undef PG8_WAIT_L
#undef PG8_BAR
#undef PG8_SCHED
}
}

#define LAS __attribute__((address_space(3)))
#ifndef DBG_ZERO
#define DBG_ZERO 0
#endif
#define DBG_NORW ((DBG_ZERO >> 1) & 1)
#ifndef DBG_RWS0
#define DBG_RWS0 0
#endif
#ifndef DBG_SLOWM
#define DBG_SLOWM 0
#endif
#ifndef DBG_SLOWR
#define DBG_SLOWR 0
#endif
#ifndef DBG_SLOWS
#define DBG_SLOWS 0
#endif
#ifndef DBG_DUP
#define DBG_DUP 0
#endif
#ifndef DBG_XSYNC
#define DBG_XSYNC 0
#endif
#ifndef USE_CG_SYNC
#define USE_CG_SYNC 0
#endif
#ifndef DBG_PROF
#define DBG_PROF 0
#endif
#ifndef DBG_DBL
#define DBG_DBL 0
#endif
#ifndef DBG_PROBE
#define DBG_PROBE 0
#endif
#ifndef DBG_MASK
#define DBG_MASK 0xfff
#endif
#ifndef DBG_FINAL
#define DBG_FINAL 2
#endif
typedef unsigned short bf16_t;
typedef short bf16x8 __attribute__((ext_vector_type(8)));
typedef float f32x4 __attribute__((ext_vector_type(4)));
typedef float f32x16 __attribute__((ext_vector_type(16)));
typedef unsigned u32x4 __attribute__((ext_vector_type(4)));
typedef unsigned u32x2 __attribute__((ext_vector_type(2)));

constexpr int L_ = 16384, D_ = 1024, NCH = 256;
constexpr int PW = 4744, PSTR = 4800, NPAD = 4864;
constexpr int C_S5U = 0, C_S5G = 512, C_RW = 1024, C_R = 1024, C_K = 1536, C_V = 2048, C_WD = 2560, C_AD = 2624, C_G = 2688;
constexpr int C_X = 3200, C_B = 3712, C_C = 3968, C_DT = 4224, C_Z = 4232, C_VD = 4744;
constexpr int MIXW = 1536;
constexpr int TEAM_LDS = 75776;
constexpr int LDS_BYTES = 2 * TEAM_LDS + 1024;

constexpr size_t OFF_PROJ = 0;
constexpr size_t OFF_R1   = OFF_PROJ + (size_t)L_ * PSTR * 2;
constexpr size_t OFF_D0   = OFF_R1 + (size_t)L_ * 1024 * 2;
constexpr size_t OFF_VF   = OFF_D0 + (size_t)L_ * 1024 * 2;
constexpr size_t OFF_WIN  = OFF_VF + (size_t)L_ * 512 * 2;
constexpr size_t OFF_WOUT = OFF_WIN + (size_t)NPAD * 1024 * 2;
constexpr size_t OFF_WGLU = OFF_WOUT + (size_t)1024 * 1536 * 2;
constexpr size_t OFF_WUP  = OFF_WGLU + (size_t)512 * 512 * 2;
constexpr size_t OFF_AUP  = OFF_WUP + 512 * 64 * 2;
constexpr size_t OFF_VUP  = OFF_AUP + 512 * 64 * 2;
constexpr size_t OFF_BB   = OFF_VUP + 512 * 64 * 2;
constexpr size_t OFF_CC   = OFF_BB + 32 * 128 * 16 * 2;
constexpr size_t OFF_ABAR = OFF_CC + 32 * 32 * 128 * 2;
constexpr size_t OFF_AB64 = OFF_ABAR + 2048 * 8;
constexpr size_t OFF_GDEC = OFF_AB64 + 2048 * 8;
constexpr size_t OFF_SSQ  = OFF_GDEC + 2048 * 4;
constexpr size_t OFF_S5E  = OFF_SSQ + (size_t)L_ * 8 * 4;
constexpr size_t OFF_BAR  = OFF_S5E + (size_t)256 * 2048 * 8;
constexpr size_t OFF_PROF = OFF_BAR + 16384;
constexpr size_t OFF_S5FLAG = OFF_PROF + 128;
constexpr size_t WS_END   = OFF_PROF + 256;
constexpr size_t OUT_MIX = 0, OUT_SEN = (size_t)L_ * MIXW * 2;

__device__ __forceinline__ int ltid() { int t = threadIdx.x; asm volatile("" : "+v"(t)); return t; }
__device__ __forceinline__ int lane_id_opaque() { int l = __builtin_amdgcn_mbcnt_hi(-1, __builtin_amdgcn_mbcnt_lo(-1, 0)); asm volatile("" : "+v"(l)); return l; }
__device__ __forceinline__ float shx(float v, int m) { return __int_as_float(__builtin_amdgcn_ds_bpermute((lane_id_opaque() ^ m) << 2, __float_as_int(v))); }
__device__ __forceinline__ float shup(float v, int d) { const int l = lane_id_opaque(); return __int_as_float(__builtin_amdgcn_ds_bpermute((l >= d ? l - d : l) << 2, __float_as_int(v))); }
#define XB_TMO      128
#define XB_XCNT(j)  (256  + 64 * (j))
#define XB_XSUB(j)  (1280 + 64 * (j))
#define XB_XGEN(j)  (2304 + 64 * (j))
#define XB_TOP      3328
#define XB_TOPGEN   3392
#define XCD_BAR_WORDS 3456
#define XB_SPIN_CAP (1u << 18)

__device__ __forceinline__ unsigned xb_ld(unsigned* p)              { return __hip_atomic_load(p, __ATOMIC_RELAXED, __HIP_MEMORY_SCOPE_AGENT); }
__device__ __forceinline__ unsigned xb_add(unsigned* p, unsigned v) { return __hip_atomic_fetch_add(p, v, __ATOMIC_RELAXED, __HIP_MEMORY_SCOPE_AGENT); }
__device__ __forceinline__ unsigned xb_xcc_id() { return (unsigned)__builtin_amdgcn_s_getreg((3 << 11) | 20) & 0xFu; }
#define XB_SPIN(cond, bar) do { unsigned _sp = 0; while (cond) { __builtin_amdgcn_s_sleep(1); \
    if ((++_sp & 255u) == 0u) { if (xb_ld(&(bar)[XB_TMO])) break; if (_sp > XB_SPIN_CAP) { atomicAdd(&(bar)[XB_TMO], 1u); break; } } } } while (0)

struct XcdBarrier {
    unsigned* bar; unsigned x;
    volatile LAS unsigned* st;
};

__device__ __forceinline__ XcdBarrier xcd_barrier_post(unsigned* bar, volatile LAS unsigned* st) {
    XcdBarrier b; b.bar = bar; b.x = xb_xcc_id(); b.st = st;
    if (threadIdx.x == 0) (void)xb_add(&bar[XB_XCNT(b.x)], 1u);
    return b;
}
__device__ __forceinline__ void xcd_barrier_complete(unsigned* bar, unsigned x, unsigned& nloc, unsigned& nx) {
    const unsigned G = gridDim.x * gridDim.y * gridDim.z;
    unsigned sum, cnt, mine, sp = 0u;
    for (;;) {
        sum = 0u; cnt = 0u; mine = 0u;
#pragma unroll
        for (unsigned j = 0; j < 16; ++j) { const unsigned c = xb_ld(&bar[XB_XCNT(j)]); sum += c; cnt += (c > 0u) ? 1u : 0u; mine = (j == x) ? c : mine; }
        if (sum == G) break;
        __builtin_amdgcn_s_sleep(1);
        if ((++sp & 255u) == 0u) { if (xb_ld(&bar[XB_TMO])) break; if (sp > XB_SPIN_CAP) { atomicAdd(&bar[XB_TMO], 1u); break; } }
    }
    nloc = mine > 0u ? mine : 1u; nx = cnt > 0u ? cnt : 1u;
}

__device__ __forceinline__ void xcd_barrier(const XcdBarrier& b) {
    asm volatile("s_waitcnt vmcnt(0)" ::: "memory");
    __syncthreads();
    if (threadIdx.x == 0) {
        unsigned* bar = b.bar;
        __builtin_amdgcn_s_waitcnt(0);
        unsigned nloc = b.st[0], nx = b.st[1];
        if (nloc == 0u) { xcd_barrier_complete(bar, b.x, nloc, nx); b.st[0] = nloc; b.st[1] = nx; }
        const unsigned old = xb_add(&bar[XB_XSUB(b.x)], 1u);
        const unsigned gen = old / nloc;
        if (old + 1u == (gen + 1u) * nloc) {
            __builtin_amdgcn_fence(__ATOMIC_RELEASE, "agent");
            asm volatile("s_waitcnt vmcnt(0)" ::: "memory");
            const unsigned og = xb_add(&bar[XB_TOP], 1u);
            const unsigned tg = og / nx;
            if (og + 1u == (tg + 1u) * nx) xb_add(&bar[XB_TOPGEN], 1u);
            else XB_SPIN(xb_ld(&bar[XB_TOPGEN]) == tg, bar);
            __builtin_amdgcn_fence(__ATOMIC_ACQUIRE, "agent");
            xb_add(&bar[XB_XGEN(b.x)], 1u);
            asm volatile("s_waitcnt vmcnt(0)" ::: "memory");
        } else {
            XB_SPIN(xb_ld(&bar[XB_XGEN(b.x)]) == gen, bar);
            __builtin_amdgcn_fence(__ATOMIC_ACQUIRE, "agent");
            asm volatile("s_waitcnt vmcnt(0)" ::: "memory");
        }
    }
    __syncthreads();
}

__device__ __forceinline__ void grid_bar(unsigned* cnt, unsigned target) {
    __threadfence();
    __syncthreads();
    if (ltid() == 0) {
        __hip_atomic_fetch_add(cnt, 1u, __ATOMIC_RELEASE, __HIP_MEMORY_SCOPE_AGENT);
        while (__hip_atomic_load(cnt, __ATOMIC_ACQUIRE, __HIP_MEMORY_SCOPE_AGENT) < target) __builtin_amdgcn_s_sleep(2);
    }
    __syncthreads();
    __threadfence();
}
#if DBG_PROF
#define PROF_T0(id) unsigned long long prof_t0_##id = 0; if (DBG_PROF == (id) && blockIdx.x == 0 && ltid() == 0) prof_t0_##id = wall_clock64()
#define PROF_T1(id, wsptr) do { if (DBG_PROF == (id) && blockIdx.x == 0 && ltid() == 0) { unsigned long long* a_ = (unsigned long long*)((wsptr) + OFF_PROF); a_[0] += wall_clock64() - prof_t0_##id; } } while (0)
#else
#define PROF_T0(id) do {} while (0)
#define PROF_T1(id, wsptr) do {} while (0)
#endif
constexpr size_t ALT_OFF = ((WS_END + 255) / 256) * 256 - OFF_WOUT;
constexpr size_t ALT_END = OFF_GDEC + ALT_OFF;
__device__ __forceinline__ size_t lofs(int layer) { return layer ? ALT_OFF : (size_t)0; }
struct Params { const float* in[35]; float* out; unsigned char* ws; };
constexpr int PTAB_OFF = 2 * 75776;
struct Ctx { LAS const unsigned* tab; float* out; unsigned char* ws;
    __device__ __forceinline__ unsigned char* wsp() const { unsigned char* w = ws; asm volatile("" : "+s"(w)); return w; }
    __device__ __forceinline__ unsigned char* outp() const { unsigned char* w = (unsigned char*)out; asm volatile("" : "+s"(w)); return w; }
    __device__ __forceinline__ const float* in(int k) const { int off = 2 * k; asm volatile("" : "+s"(off)); LAS const unsigned* q = tab + off;
        const unsigned lo = __builtin_amdgcn_readfirstlane(q[0]), hi = __builtin_amdgcn_readfirstlane(q[1]);
        return (const float*)(((unsigned long long)hi << 32) | lo); } };

typedef __bf16 bf16x2_n __attribute__((ext_vector_type(2)));
typedef float f32x2_n __attribute__((ext_vector_type(2)));
__device__ __forceinline__ bf16_t f2bf(float f) { const __bf16 b = (__bf16)f; return __builtin_bit_cast(unsigned short, b); }
__device__ __forceinline__ float bf2f(unsigned b) { return __uint_as_float(b << 16); }
__device__ __forceinline__ unsigned pack2(float lo, float hi) { const f32x2_n v = {lo, hi}; const bf16x2_n b = __builtin_convertvector(v, bf16x2_n); return __builtin_bit_cast(unsigned, b); }
__device__ __forceinline__ float sigmoidf_(float x) { return __builtin_amdgcn_rcpf(1.0f + __expf(-x)); }
__device__ __forceinline__ float siluf_(float x) { return x * __builtin_amdgcn_rcpf(1.0f + __expf(-x)); }
__device__ __forceinline__ float softplusf_(float z) { return z > 20.f ? z : log1pf(__expf(z)); }
__device__ __forceinline__ float softplus_pos_(float z) { return z > 20.f ? z : __logf(1.0f + __expf(z)); }
__device__ __forceinline__ float tanh_fast_(float x) { return 1.0f - 2.0f * __builtin_amdgcn_rcpf(1.0f + __expf(2.0f * x)); }
__device__ __forceinline__ void unpack8(u32x4 v, float* o) {
#pragma unroll
    for (int i = 0; i < 4; ++i) { o[2 * i] = __uint_as_float(v[i] << 16); o[2 * i + 1] = __uint_as_float(v[i] & 0xffff0000u); }
}
__device__ __forceinline__ u32x4 pack8(const float* o) { u32x4 v; v.x = pack2(o[0], o[1]); v.y = pack2(o[2], o[3]); v.z = pack2(o[4], o[5]); v.w = pack2(o[6], o[7]); return v; }
__device__ __forceinline__ void ld16(const bf16_t* p, float* o) { u32x4 a = *(const u32x4*)p, b = *(const u32x4*)(p + 8); unpack8(a, o); unpack8(b, o + 8); }
__device__ __forceinline__ void ld16_lerp(const bf16_t* crow, const bf16_t* prow, const float* mu, float* o) {
    float c[16], q[16]; ld16(crow, c);
    if (prow) ld16(prow, q); else {
#pragma unroll
        for (int i = 0; i < 16; ++i) q[i] = 0.f; }
#pragma unroll
    for (int i = 0; i < 16; ++i) o[i] = c[i] + (q[i] - c[i]) * mu[i];
}
__device__ __forceinline__ void ld8_lerp(const bf16_t* crow, const bf16_t* prow, const float* mu, float* o) {
    float c[8], q[8]; unpack8(*(const u32x4*)crow, c);
    if (prow) unpack8(*(const u32x4*)prow, q); else {
#pragma unroll
        for (int i = 0; i < 8; ++i) q[i] = 0.f; }
#pragma unroll
    for (int i = 0; i < 8; ++i) o[i] = c[i] + (q[i] - c[i]) * mu[i];
}
__device__ __forceinline__ void st16_lds(LAS bf16_t* p, const float* o) { *(LAS u32x4*)p = pack8(o); *(LAS u32x4*)(p + 8) = pack8(o + 8); }
__device__ __forceinline__ void st16_g(bf16_t* p, const float* o) { *(u32x4*)p = pack8(o); *(u32x4*)(p + 8) = pack8(o + 8); }

__device__ __forceinline__ f32x16 mma_ll(f32x16 acc, const LAS bf16_t* A, int lda, const LAS bf16_t* B, int ldb, int K, int lane) {
    const LAS bf16_t* pa = A + (lane & 31) * lda + 8 * (lane >> 5);
    const LAS bf16_t* pb = B + (lane & 31) * ldb + 8 * (lane >> 5);
#pragma unroll 4
    for (int k = 0; k < K; k += 16) { bf16x8 a = *(const LAS bf16x8*)(pa + k); bf16x8 b = *(const LAS bf16x8*)(pb + k); acc = __builtin_amdgcn_mfma_f32_32x32x16_bf16(a, b, acc, 0, 0, 0); }
    return acc;
}
__device__ __forceinline__ f32x16 mma_lg(f32x16 acc, const LAS bf16_t* A, int lda, const bf16_t* B, int ldb, int K, int lane) {
    const LAS bf16_t* pa = A + (lane & 31) * lda + 8 * (lane >> 5);
    const bf16_t* pb = B + (size_t)(lane & 31) * ldb + 8 * (lane >> 5);
#pragma unroll 4
    for (int k = 0; k < K; k += 16) { bf16x8 a = *(const LAS bf16x8*)(pa + k); bf16x8 b = *(const bf16x8*)(pb + k); acc = __builtin_amdgcn_mfma_f32_32x32x16_bf16(a, b, acc, 0, 0, 0); }
    return acc;
}
__device__ __forceinline__ f32x16 mma_gg(f32x16 acc, const bf16_t* A, int lda, const bf16_t* B, int ldb, int K, int lane) {
    const bf16_t* pa = A + (size_t)(lane & 31) * lda + 8 * (lane >> 5);
    const bf16_t* pb = B + (size_t)(lane & 31) * ldb + 8 * (lane >> 5);
#pragma unroll 4
    for (int k = 0; k < K; k += 16) { bf16x8 a = *(const bf16x8*)(pa + k); bf16x8 b = *(const bf16x8*)(pb + k); acc = __builtin_amdgcn_mfma_f32_32x32x16_bf16(a, b, acc, 0, 0, 0); }
    return acc;
}
#define ACC_ROW(j, lane) (((j) & 3) + 8 * ((j) >> 2) + 4 * ((lane) >> 5))
__device__ __forceinline__ f32x16 zero16() { f32x16 z;
#pragma unroll
    for (int i = 0; i < 16; ++i) z[i] = 0.f; return z; }

using pg8::Unit; using pg8::BM; using pg8::HALF;
struct EpiProj {
    static constexpr bool PERM = true, AFTER_DRAIN = false;
    bf16_t* O;
    __device__ __forceinline__ void operator()(const f32x4 (&acc)[2][2][4][2], const Unit& u, int wr, int wc, int fr, int fq) const {
        const int row0 = u.pm * BM + wr * 64 + fr, col0 = u.pn * BM + wc * 32 + 8 * fq;
#pragma unroll
        for (int ai = 0; ai < 2; ++ai)
#pragma unroll
            for (int m = 0; m < 4; ++m) { bf16_t* rowp = O + (size_t)(row0 + ai * HALF + m * 16) * PSTR + col0;
#pragma unroll
                for (int bj = 0; bj < 2; ++bj) { const f32x4 v0 = acc[ai][bj][m][0], v1 = acc[ai][bj][m][1];
                    u32x4 w; w.x = pack2(v0[0], v0[1]); w.y = pack2(v0[2], v0[3]); w.z = pack2(v1[0], v1[1]); w.w = pack2(v1[2], v1[3]);
                    if (col0 + bj * HALF < PSTR) *(u32x4*)(rowp + bj * HALF) = w; } }
    }
};
struct EpiD0 {
    static constexpr bool PERM = true, AFTER_DRAIN = false;
    bf16_t* O;
    __device__ __forceinline__ void operator()(const f32x4 (&acc)[2][2][4][2], const Unit& u, int wr, int wc, int fr, int fq) const {
        const int row0 = u.pm * BM + wr * 64 + fr, col0 = u.pn * BM + wc * 32 + 8 * fq;
#pragma unroll
        for (int ai = 0; ai < 2; ++ai)
#pragma unroll
            for (int m = 0; m < 4; ++m) { bf16_t* rowp = O + (size_t)(row0 + ai * HALF + m * 16) * 1024 + col0;
#pragma unroll
                for (int bj = 0; bj < 2; ++bj) { const f32x4 v0 = acc[ai][bj][m][0], v1 = acc[ai][bj][m][1];
                    u32x4 w; w.x = pack2(v0[0], v0[1]); w.y = pack2(v0[2], v0[3]); w.z = pack2(v1[0], v1[1]); w.w = pack2(v1[2], v1[3]);
                    *(u32x4*)(rowp + bj * HALF) = w; } }
    }
};
struct EpiH2 {
    static constexpr bool PERM = false, AFTER_DRAIN = false;
    float* O;
    __device__ __forceinline__ void operator()(const f32x4 (&acc)[2][2][4][2], const Unit& u, int wr, int wc, int fr, int fq) const {
        const int row0 = u.pm * BM + wr * 64 + fr, col0 = u.pn * BM + wc * 32 + 4 * fq;
#pragma unroll
        for (int ai = 0; ai < 2; ++ai)
#pragma unroll
            for (int m = 0; m < 4; ++m) { float* rowp = O + (size_t)(row0 + ai * HALF + m * 16) * 1024 + col0;
#pragma unroll
                for (int bj = 0; bj < 2; ++bj)
#pragma unroll
                    for (int n = 0; n < 2; ++n) *(f32x4*)(rowp + bj * HALF + n * 16) = acc[ai][bj][m][n]; }
    }
};
struct EpiGlu {
    static constexpr bool PERM = true, AFTER_DRAIN = false;
    bf16_t* MIX; const bf16_t* Y; const bf16_t* PROJ; const float* bias;
    __device__ __forceinline__ void operator()(const f32x4 (&acc)[2][2][4][2], const Unit& u, int wr, int wc, int fr, int fq) const {
        const int row0 = u.pm * BM + wr * 64 + fr, col0 = u.pn * BM + wc * 32 + 8 * fq;
#pragma unroll
        for (int ai = 0; ai < 2; ++ai)
#pragma unroll
            for (int m = 0; m < 4; ++m) { const int row = row0 + ai * HALF + m * 16;
#pragma unroll
                for (int bj = 0; bj < 2; ++bj) { const int col = col0 + bj * HALF;
                    float z[8], y[8], g[8], o[8];
                    const f32x4 v0 = acc[ai][bj][m][0], v1 = acc[ai][bj][m][1];
#pragma unroll
                    for (int e = 0; e < 4; ++e) { z[e] = v0[e] + bias[col + e]; z[4 + e] = v1[e] + bias[col + 4 + e]; }
                    unpack8(*(const u32x4*)(Y + (size_t)row * PSTR + C_S5U + col), y);
                    unpack8(*(const u32x4*)(PROJ + (size_t)row * PSTR + C_S5G + col), g);
#pragma unroll
                    for (int e = 0; e < 8; ++e) o[e] = (DBG_ZERO & 1) ? 0.f : ((DBG_DBL & 1) ? 2.f : 1.f) * y[e] * sigmoidf_(z[e]) * siluf_(g[e]);
                    *(u32x4*)(MIX + (size_t)row * MIXW + col) = pack8(o); } }
    }
};

__device__ __forceinline__ void tconv(bf16_t* dst, int N, int K, const float* src1, int ld1, int n1, const float* src2, int ld2, int n2, int kvalid,
                      const float* sc, int ks0, LAS float* tile, int& rot, int bidx, int nb) {
    const int tid = ltid(); const int tn = N / 64, tk = K / 64, nt = tn * tk;
    for (int t = (bidx + rot) % nb; t < nt; t += nb) {
        const int n0 = (t % tn) * 64, k0 = (t / tn) * 64;
#pragma unroll
        for (int e = 0; e < 8; ++e) { const int idx = e * 512 + tid, kk = idx >> 6, nn = idx & 63, k = k0 + kk, n = n0 + nn;
            float v = 0.f;
            if (k < kvalid) { if (n < n1) v = src1[(size_t)k * ld1 + n]; else if (src2 && n < n2) v = src2[(size_t)k * ld2 + (n - n1)]; }
            if (sc && k >= ks0) v *= sc[k - ks0];
            tile[kk * 65 + nn] = v; }
        __syncthreads();
        { const int n = tid >> 3, ks = (tid & 7) * 8; float o[8];
#pragma unroll
          for (int j = 0; j < 8; ++j) o[j] = tile[(ks + j) * 65 + n];
          *(u32x4*)(dst + (size_t)(n0 + n) * K + k0 + ks) = pack8(o); }
        __syncthreads();
    }
    rot += nt;
}

__device__ __forceinline__ void prep_weights(const Ctx& p, int layer, LAS unsigned char* lds, int bidx, int nb) {
    unsigned char* ws = p.wsp(); const int tid = ltid(); const size_t lo = lofs(layer);
    LAS float* tile = (LAS float*)lds; int rot = 0;
    tconv((bf16_t*)(ws + OFF_WIN), NPAD, 1024, p.in(2) + (size_t)layer * 1024 * PW, PW, PW, layer ? p.in(3) : nullptr, 32, PW + 32, 1024, p.in(1) + layer * 1024, 0, tile, rot, bidx, nb);
    tconv((bf16_t*)(ws + OFF_WOUT + lo), 1024, 1536, p.in(33) + (size_t)layer * 1536 * 1024, 1024, 1024, nullptr, 0, 0, 1536, p.in(32) + layer * 512, 1024, tile, rot, bidx, nb);
    tconv((bf16_t*)(ws + OFF_WGLU + lo), 512, 512, p.in(12) + (size_t)layer * 512 * 512, 512, 512, nullptr, 0, 0, 512, nullptr, 0, tile, rot, bidx, nb);
    tconv((bf16_t*)(ws + OFF_WUP + lo), 512, 64, p.in(15) + (size_t)layer * 64 * 512, 512, 512, nullptr, 0, 0, 64, nullptr, 0, tile, rot, bidx, nb);
    tconv((bf16_t*)(ws + OFF_AUP + lo), 512, 64, p.in(17) + (size_t)layer * 64 * 512, 512, 512, nullptr, 0, 0, 64, nullptr, 0, tile, rot, bidx, nb);
    if (layer) tconv((bf16_t*)(ws + OFF_VUP + lo), 512, 64, p.in(25), 512, 512, nullptr, 0, 0, 32, nullptr, 0, tile, rot, bidx, nb);
    { const int gt = bidx * 512 + tid;
      if (gt < 2048) { const int g = gt >> 6, pp = gt & 63;
        const float dt = expf(p.in(4)[layer * 32 + g]); const float ar = p.in(5)[layer * 2048 + gt], ai = p.in(6)[layer * 2048 + gt];
        const float mag = expf(dt * ar); const float abr = mag * cosf(dt * ai), abi = mag * sinf(dt * ai);
        const float den = ar * ar + ai * ai; const float fre = ((abr - 1.0f) * ar + abi * ai) / den, fim = (abi * ar - (abr - 1.0f) * ai) / den;
        bf16_t* BB = (bf16_t*)(ws + OFF_BB + lo); bf16_t* CC = (bf16_t*)(ws + OFF_CC + lo);
        const float* br = p.in(7) + (size_t)layer * 32768 + (size_t)gt * 16; const float* bi = p.in(8) + (size_t)layer * 32768 + (size_t)gt * 16;
#pragma unroll 1
        for (int c = 0; c < 16; ++c) { BB[(g * 128 + pp) * 16 + c] = f2bf(fre * br[c] - fim * bi[c]); BB[(g * 128 + 64 + pp) * 16 + c] = f2bf(fre * bi[c] + fim * br[c]); }
        const float* cr = p.in(9) + (size_t)layer * 32768 + (size_t)g * 1024; const float* ci = p.in(10) + (size_t)layer * 32768 + (size_t)g * 1024;
#pragma unroll 1
        for (int c = 0; c < 32; ++c) { CC[(g * 32 + c) * 128 + pp] = c < 16 ? f2bf(cr[c * 64 + pp]) : (bf16_t)0; CC[(g * 32 + c) * 128 + 64 + pp] = c < 16 ? f2bf(-ci[c * 64 + pp]) : (bf16_t)0; }
        float2* AB = (float2*)(ws + OFF_ABAR + lo); float2* AB64 = (float2*)(ws + OFF_AB64 + lo);
        AB[gt] = make_float2(abr, abi);
        float xr = abr, xi = abi;
#pragma unroll 1
        for (int s = 0; s < 6; ++s) { const float nr = xr * xr - xi * xi, ni = 2.f * xr * xi; xr = nr; xi = ni; }
        AB64[gt] = make_float2(xr, xi); } }
}
__device__ __forceinline__ void prep_hb(const Ctx& p, int layer) {
    unsigned char* ws = p.wsp(); const int tid = ltid(), lane = tid & 63;
    { const float* x = p.in(0); const bf16_t* D0 = (const bf16_t*)(ws + OFF_D0); bf16_t* hb = (bf16_t*)(ws + OFF_R1);
      const int wv = blockIdx.x * 8 + (tid >> 6), nw = gridDim.x * 8;
      for (int t = wv; t < L_; t += 2 * nw) {
          f32x4 xa[4], xb[4]; u32x2 da[4], db[4];
#pragma unroll
          for (int j = 0; j < 4; ++j) { const size_t oa = (size_t)t * 1024 + j * 256 + lane * 4, ob = oa + (size_t)nw * 1024;
              xa[j] = *(const f32x4*)(x + oa); xb[j] = *(const f32x4*)(x + ob);
              if (layer) { da[j] = *(const u32x2*)(D0 + oa); db[j] = *(const u32x2*)(D0 + ob); } else { da[j] = (u32x2){0u, 0u}; db[j] = (u32x2){0u, 0u}; } }
          float sa = 0.f, sb = 0.f;
#pragma unroll
          for (int j = 0; j < 4; ++j) {
              xa[j][0] += __uint_as_float(da[j].x << 16); xa[j][1] += __uint_as_float(da[j].x & 0xffff0000u); xa[j][2] += __uint_as_float(da[j].y << 16); xa[j][3] += __uint_as_float(da[j].y & 0xffff0000u);
              xb[j][0] += __uint_as_float(db[j].x << 16); xb[j][1] += __uint_as_float(db[j].x & 0xffff0000u); xb[j][2] += __uint_as_float(db[j].y << 16); xb[j][3] += __uint_as_float(db[j].y & 0xffff0000u);
#pragma unroll
              for (int e = 0; e < 4; ++e) { sa += xa[j][e] * xa[j][e]; sb += xb[j][e] * xb[j][e]; } }
#pragma unroll
          for (int o = 32; o > 0; o >>= 1) { sa += shx(sa, o); sb += shx(sb, o); }
          const float ra = rsqrtf(sa * (1.0f / 1024.0f) + 1e-5f), rb = rsqrtf(sb * (1.0f / 1024.0f) + 1e-5f);
#pragma unroll
          for (int j = 0; j < 4; ++j) { const size_t oa = (size_t)t * 1024 + j * 256 + lane * 4, ob = oa + (size_t)nw * 1024; u32x2 w;
              w.x = pack2(xa[j][0] * ra, xa[j][1] * ra); w.y = pack2(xa[j][2] * ra, xa[j][3] * ra); *(u32x2*)(hb + oa) = w;
              w.x = pack2(xb[j][0] * rb, xb[j][1] * rb); w.y = pack2(xb[j][2] * rb, xb[j][3] * rb); *(u32x2*)(hb + ob) = w; } } }
}


#if DBG_PROBE
__device__ __forceinline__ void phase_probe(const Ctx& p) {
    unsigned char* ws = p.wsp(); bf16_t* R = (bf16_t*)(ws + OFF_R1);
    const bf16_t* PROJ = (const bf16_t*)(ws + OFF_PROJ); const bf16_t* MIX = (const bf16_t*)(p.outp() + OUT_MIX);
    const bf16_t* YB = (const bf16_t*)(p.outp() + OUT_SEN); const bf16_t* D0 = (const bf16_t*)(ws + OFF_D0);
    const float* SSQ = (const float*)(ws + OFF_SSQ);
    const size_t n = (size_t)L_ * 1024;
    for (size_t i = (size_t)blockIdx.x * 512 + ltid(); i < n; i += (size_t)gridDim.x * 512) {
        const int t = (int)(i >> 10), c = (int)(i & 1023); float v = 0.f;
        if (DBG_PROBE == 1) { for (int k = 0; k < 4; ++k) v += bf2f(PROJ[(size_t)t * PSTR + c + 1024 * k]); if (c < 704) v += bf2f(PROJ[(size_t)t * PSTR + 4096 + c]); }
        if (DBG_PROBE == 2) v = bf2f(MIX[(size_t)t * MIXW + (c & 511)]);
        if (DBG_PROBE == 3) v = bf2f(MIX[(size_t)t * MIXW + 512 + (c & 511)]);
        if (DBG_PROBE == 4) v = bf2f(MIX[(size_t)t * MIXW + 1024 + (c & 511)]);
        if (DBG_PROBE == 5) v = bf2f(D0[i]);
        if (DBG_PROBE == 6) v = bf2f(YB[(size_t)t * 512 + (c & 511)]);
        if (DBG_PROBE == 7) v = SSQ[t * 8 + (c & 7)];
        if (DBG_PROBE == 8) v = bf2f(((const bf16_t*)(ws + OFF_WIN))[i]) + bf2f(((const bf16_t*)(ws + OFF_WOUT))[i & (1024 * 1536 - 1)]);
        if (DBG_PROBE == 9) v = ((const float*)(ws + OFF_S5E))[i & (1048576 - 1)];
        if (DBG_PROBE == 10) v = bf2f(((const bf16_t*)(ws + OFF_BB))[i & 65535]) + bf2f(((const bf16_t*)(ws + OFF_CC))[i & 131071]) + ((const float*)(ws + OFF_ABAR))[i & 4095] + ((const float*)(ws + OFF_AB64))[i & 4095];
        R[i] = f2bf(v);
    }
}
#endif
__device__ __forceinline__ void phase_final(const Ctx& p) {
    const bf16_t* h2 = (const bf16_t*)(p.wsp() + OFF_PROJ);     const float* g = p.in(34); float* out = p.out; const float* x = p.in(0); const bf16_t* D0 = (const bf16_t*)(p.wsp() + OFF_D0);
    const int tid = ltid(), lane = tid & 63; const int wv = blockIdx.x * 8 + (tid >> 6), nw = gridDim.x * 8;
#if DBG_PROF
    const unsigned long long* pa_ = (const unsigned long long*)(p.wsp() + OFF_PROF); const unsigned long long tot_ = wall_clock64() - pa_[1];
    const int zrows = 512 * (int)((double)pa_[0] / (double)tot_ * 32.0 + 0.5);
#endif
    for (int t = wv; t < L_; t += 2 * nw) {
        f32x4 va[4], vb[4]; u32x2 da[4], db[4], ha[4], hb2[4];
#pragma unroll
        for (int j = 0; j < 4; ++j) { const size_t oa = (size_t)t * 1024 + j * 256 + lane * 4, ob = oa + (size_t)nw * 1024;
            va[j] = *(const f32x4*)(x + oa); vb[j] = *(const f32x4*)(x + ob);
            da[j] = *(const u32x2*)(D0 + oa); db[j] = *(const u32x2*)(D0 + ob);
            ha[j] = *(const u32x2*)(h2 + oa); hb2[j] = *(const u32x2*)(h2 + ob); }
        float sa = 0.f, sb = 0.f;
#pragma unroll
        for (int j = 0; j < 4; ++j) {
            va[j][0] += __uint_as_float(da[j].x << 16) + __uint_as_float(ha[j].x << 16); va[j][1] += __uint_as_float(da[j].x & 0xffff0000u) + __uint_as_float(ha[j].x & 0xffff0000u);
            va[j][2] += __uint_as_float(da[j].y << 16) + __uint_as_float(ha[j].y << 16); va[j][3] += __uint_as_float(da[j].y & 0xffff0000u) + __uint_as_float(ha[j].y & 0xffff0000u);
            vb[j][0] += __uint_as_float(db[j].x << 16) + __uint_as_float(hb2[j].x << 16); vb[j][1] += __uint_as_float(db[j].x & 0xffff0000u) + __uint_as_float(hb2[j].x & 0xffff0000u);
            vb[j][2] += __uint_as_float(db[j].y << 16) + __uint_as_float(hb2[j].y << 16); vb[j][3] += __uint_as_float(db[j].y & 0xffff0000u) + __uint_as_float(hb2[j].y & 0xffff0000u);
#pragma unroll
            for (int e = 0; e < 4; ++e) { sa += va[j][e] * va[j][e]; sb += vb[j][e] * vb[j][e]; } }
#pragma unroll
        for (int o = 32; o > 0; o >>= 1) { sa += shx(sa, o); sb += shx(sb, o); }
        const float ra = rsqrtf(sa * (1.0f / 1024.0f) + 1e-5f), rb = rsqrtf(sb * (1.0f / 1024.0f) + 1e-5f);
#pragma unroll
        for (int j = 0; j < 4; ++j) { const size_t oa = (size_t)t * 1024 + j * 256 + lane * 4, ob = oa + (size_t)nw * 1024; const f32x4 gv = *(const f32x4*)(g + j * 256 + lane * 4);
            *(f32x4*)(out + oa) = va[j] * ra * gv; *(f32x4*)(out + ob) = vb[j] * rb * gv; }
    }
}

__device__ __forceinline__ void m2_normalize(const Ctx& p, int b0, int nb) {
    bf16_t* mix = (bf16_t*)(p.outp() + OUT_MIX); const float* ssq = (const float*)(p.wsp() + OFF_SSQ);
    const int tid = ltid(), lane = tid & 63; const int wv = (blockIdx.x - b0) * 8 + (tid >> 6), nw = nb * 8;
    for (int t = wv; t < L_; t += nw) {
        float s = 0.f;
#pragma unroll
        for (int h = 0; h < 8; ++h) s += ssq[t * 8 + h];
        const float rs = ((DBG_DBL & 4) ? 2.f : 1.f) * rsqrtf(s * (1.0f / 512.0f) + 1e-5f);
        bf16_t* ptr = mix + (size_t)t * MIXW + 1024 + lane * 8; float o[8]; unpack8(*(const u32x4*)ptr, o);
#pragma unroll
        for (int e = 0; e < 8; ++e) o[e] *= rs;
        *(u32x4*)ptr = pack8(o);
    }
}

constexpr int TS = 72;
constexpr int FS = 68;
template <int PASS>
__device__ __forceinline__ void rwkv_pass(const Ctx& p, int layer, LAS unsigned char* tl, int team_gid, int nteams) {
    unsigned char* ws = p.wsp();
    const int tt0 = ltid() & 255;
    const bf16_t* PROJ = (const bf16_t*)(ws + OFF_PROJ);
    bf16_t* MtG = (bf16_t*)(ws + OFF_R1); bf16_t* NG = MtG + (size_t)2048 * 4096;
    bf16_t* SEN = (bf16_t*)(p.outp() + OUT_SEN);
    bf16_t* MIX = (bf16_t*)(p.outp() + OUT_MIX);
    bf16_t* VF = (bf16_t*)(ws + OFF_VF);
    const bf16_t* WUP = (const bf16_t*)(ws + OFF_WUP + lofs(layer)); const bf16_t* AUP = (const bf16_t*)(ws + OFF_AUP + lofs(layer)); const bf16_t* VUP = (const bf16_t*)(ws + OFF_VUP + lofs(layer));
    const float* mu = p.in(14) + layer * 2176;
    LAS float* PT = (LAS float*)(tl + 73728);
    LAS bf16_t* TW = (LAS bf16_t*)(tl + 0); LAS bf16_t* TA = (LAS bf16_t*)(tl + 9216); LAS bf16_t* TV = (LAS bf16_t*)(tl + 18432);
    LAS float* LW = (LAS float*)(tl + 27648); LAS bf16_t* AS = (LAS bf16_t*)(tl + 45056); LAS bf16_t* SV = (LAS bf16_t*)(tl + 54272);
    LAS bf16_t* At = (LAS bf16_t*)(tl + (PASS == 1 ? 0 : 36864));
    LAS bf16_t* VT = (LAS bf16_t*)(tl + 9216);
    LAS bf16_t* BT = (LAS bf16_t*)(tl + 18432);
    LAS bf16_t* KT = (LAS bf16_t*)(tl + 27648);
    LAS bf16_t* Rn = (LAS bf16_t*)(tl + 0);
    LAS bf16_t* Bn = (LAS bf16_t*)(tl + (PASS == 1 ? 36864 : 18432));
    LAS bf16_t* Kn = (LAS bf16_t*)(tl + (PASS == 1 ? 46080 : 27648));
    LAS float* AAB = (LAS float*)(tl + (PASS == 1 ? 36864 : 18432));
    LAS bf16_t* AK = (LAS bf16_t*)(tl + (PASS == 1 ? 55296 : 46080));
    LAS float* XF = (LAS float*)(tl + (PASS == 1 ? 55296 : 36864));
    LAS bf16_t* UT0 = (LAS bf16_t*)(tl + (PASS == 1 ? 55296 : 36864));
    LAS bf16_t* UT1 = (LAS bf16_t*)(tl + 64512);
    LAS bf16_t* ARB = (LAS bf16_t*)(tl + 55296); LAS bf16_t* ARK = (LAS bf16_t*)(tl + 64512);

    for (int item = team_gid; item < 2048; item += nteams) {
        const int c = item >> 3, h = item & 7, t0 = c * 64;
        int tt = tt0; asm volatile("" : "+v"(tt));
        const int wq = __builtin_amdgcn_readfirstlane(tt >> 6), lane = tt & 63, ti = wq >> 1, tj = wq & 1;
        const int t = tt >> 2, seg = tt & 3, gt = t0 + t;
        const bf16_t* crow = PROJ + (size_t)gt * PSTR; const bf16_t* prow = gt > 0 ? crow - PSTR : nullptr;
        float inv; u32x4 kpk0, kpk1;
        { float kk[16]; const int co = 64 * h + seg * 16; const float* kkp = p.in(19) + layer * 512 + co; float ssq = 0.f;
          ld16_lerp(crow + C_K + co, prow ? prow + C_K + co : nullptr, mu + (C_K - C_RW) + co, kk);
#pragma unroll
          for (int e = 0; e < 16; ++e) { const float x = kk[e] * kkp[e]; ssq += x * x; }
          ssq += shx(ssq, 1); ssq += shx(ssq, 2);
          inv = 1.0f / fmaxf(sqrtf(ssq), 1e-12f); kpk0 = pack8(kk); kpk1 = pack8(kk + 8); }
        PROF_T0(3);
        { float o[16];
          ld16_lerp(crow + C_WD + seg * 16, prow ? prow + C_WD + seg * 16 : nullptr, mu + (C_WD - C_RW) + seg * 16, o);
#pragma unroll
          for (int e = 0; e < 16; ++e) o[e] = tanh_fast_(o[e]);
          st16_lds(TW + t * TS + seg * 16, o);
          ld16_lerp(crow + C_AD + seg * 16, prow ? prow + C_AD + seg * 16 : nullptr, mu + (C_AD - C_RW) + seg * 16, o);
          st16_lds(TA + t * TS + seg * 16, o);
          if (layer) { if (seg < 2) ld16_lerp(crow + C_VD + seg * 16, prow ? prow + C_VD + seg * 16 : nullptr, p.in(24) + seg * 16, o); else {
#pragma unroll
                  for (int e = 0; e < 16; ++e) o[e] = 0.f; }
              st16_lds(TV + t * TS + seg * 16, o); } }
        __syncthreads();
        { f32x16 aw = mma_lg(zero16(), TW + ti * 32 * TS, TS, WUP + (size_t)(64 * h + tj * 32) * 64, 64, 64, lane);
          f32x16 aa = mma_lg(zero16(), TA + ti * 32 * TS, TS, AUP + (size_t)(64 * h + tj * 32) * 64, 64, 64, lane);
          f32x16 av = zero16(); if (layer) av = mma_lg(av, TV + ti * 32 * TS, TS, VUP + (size_t)(64 * h + tj * 32) * 64, 64, 64, lane);
          const int cc = tj * 32 + (lane & 31), ch = 64 * h + cc;
          const float w0 = p.in(16)[layer * 512 + ch], a0 = p.in(18)[layer * 512 + ch], v0 = layer ? p.in(26)[ch] : 0.f;
#pragma unroll
          for (int j = 0; j < 16; ++j) { const int r = ti * 32 + ACC_ROW(j, lane);
              const float xw = w0 + aw[j];
              LW[r * FS + cc] = -0.60653065971f * sigmoidf_(xw);
              AS[r * TS + cc] = f2bf(sigmoidf_(a0 + aa[j]));
              if (layer) SV[r * TS + cc] = f2bf(sigmoidf_(v0 + av[j])); } }
        __syncthreads();
        { LAS float* TOT = (LAS float*)(tl + 73728 + 256);
          const int rb = wq * 16; float lv[16];
#pragma unroll
          for (int j = 0; j < 16; ++j) lv[j] = LW[(rb + j) * FS + lane];
#pragma unroll
          for (int j = 1; j < 16; ++j) lv[j] += lv[j - 1];
          TOT[wq * 64 + lane] = lv[15];
          __syncthreads();
          float off = 0.f;
#pragma unroll
          for (int b = 0; b < 3; ++b) if (b < wq) off += TOT[b * 64 + lane];
#pragma unroll
          for (int j = 0; j < 16; ++j) LW[(rb + j) * FS + lane] = lv[j] + off; }
        __syncthreads();
        PROF_T1(3, ws);
        PROF_T0(2);
        float vv[16]; float bonus = 0.f;
        float hA0[8], hB0[8], hA1[8], hB1[8];
#define S4_HALF(HF, HA, HB) do { \
          const int c8 = seg * 16 + (HF) * 8, co8 = 64 * h + c8; \
          float cum[8], cumm[8], av_[8], sv_[8], rr[8], kq[8], v8[8]; \
          _Pragma("unroll") for (int e = 0; e < 8; ++e) { cum[e] = LW[t * FS + c8 + e]; cumm[e] = t > 0 ? LW[(t - 1) * FS + c8 + e] : 0.f; av_[e] = bf2f(AS[t * TS + c8 + e]); sv_[e] = layer ? bf2f(SV[t * TS + c8 + e]) : 0.f; } \
          if (t == 63) { _Pragma("unroll") for (int e = 0; e < 8; ++e) PT[c8 + e] = __expf(cum[e]); } \
          ld8_lerp(crow + C_R + co8, prow ? prow + C_R + co8 : nullptr, mu + (C_R - C_RW) + co8, rr); \
          unpack8((HF) ? kpk1 : kpk0, kq); \
          ld8_lerp(crow + C_V + co8, prow ? prow + C_V + co8 : nullptr, mu + (C_V - C_RW) + co8, v8); \
          if (layer) { float vf[8]; unpack8(*(const u32x4*)(VF + (size_t)gt * 512 + co8), vf); \
              _Pragma("unroll") for (int e = 0; e < 8; ++e) v8[e] = v8[e] + (vf[e] - v8[e]) * sv_[e]; } \
          else if (PASS == 3) *(u32x4*)(VF + (size_t)gt * 512 + co8) = pack8(v8); \
          const float* kkp8 = p.in(19) + layer * 512 + co8; const float* kap8 = p.in(20) + layer * 512 + co8; const float* rkp8 = p.in(21) + layer * 512 + co8; \
          float oa[8], orr[8]; \
          _Pragma("unroll") for (int e = 0; e < 8; ++e) { const float kkn = kq[e] * kkp8[e] * inv; const float a = av_[e]; const float k2 = kq[e] * (1.0f + (a - 1.0f) * kap8[e]); \
              const float Pt = __expf(cum[e]), Pm = __expf(cumm[e]), iP = __builtin_amdgcn_rcpf(Pt); \
              oa[e] = -kkn * Pm; const float obv = kkn * a * iP; const float okv = k2 * iP; orr[e] = rr[e] * Pt; bonus += rr[e] * k2 * rkp8[e]; \
              vv[(HF) * 8 + e] = v8[e]; VT[(c8 + e) * TS + t] = f2bf(v8[e]); \
              if (PASS == 1) { BT[(c8 + e) * TS + t] = f2bf(obv); HA[e] = obv; HB[e] = okv; } else { HA[e] = oa[e]; HB[e] = okv; oa[e] = obv; } } \
          if (PASS == 1) *(LAS u32x4*)(At + t * TS + c8) = pack8(oa); \
          else { *(LAS u32x4*)(Rn + t * TS + c8) = pack8(orr); *(LAS u32x4*)(Bn + t * TS + c8) = pack8(oa); } \
        } while (0)
        S4_HALF(0, hA0, hB0);
        if (PASS == 3) __builtin_amdgcn_sched_barrier(0);
        S4_HALF(1, hA1, hB1);
#undef S4_HALF
        bonus += shx(bonus, 1); bonus += shx(bonus, 2);
        __syncthreads();
        { const int c0 = seg * 16;
          if (PASS == 1) { *(LAS u32x4*)(Bn + t * TS + c0) = pack8(hA0); *(LAS u32x4*)(Bn + t * TS + c0 + 8) = pack8(hA1);
              *(LAS u32x4*)(Kn + t * TS + c0) = pack8(hB0); *(LAS u32x4*)(Kn + t * TS + c0 + 8) = pack8(hB1);
#pragma unroll
              for (int e = 0; e < 8; ++e) { KT[(c0 + e) * TS + t] = f2bf(hB0[e]); KT[(c0 + 8 + e) * TS + t] = f2bf(hB1[e]); } }
          else { *(LAS u32x4*)(At + t * TS + c0) = pack8(hA0); *(LAS u32x4*)(At + t * TS + c0 + 8) = pack8(hA1);
              *(LAS u32x4*)(Kn + t * TS + c0) = pack8(hB0); *(LAS u32x4*)(Kn + t * TS + c0 + 8) = pack8(hB1); } }
        __syncthreads();
        PROF_T1(2, ws);
        PROF_T0(4);
        { const int s = tj * 32 + (lane & 31);
          { f32x16 ak = mma_ll(zero16(), At + ti * 32 * TS, TS, Kn + tj * 32 * TS, TS, 64, lane);
#pragma unroll
            for (int j = 0; j < 16; ++j) { const int r = ti * 32 + ACC_ROW(j, lane); AK[r * TS + s] = (s < r) ? f2bf(ak[j]) : (bf16_t)0; } }
          if (PASS == 3) {
              { f32x16 rb = mma_ll(zero16(), Rn + ti * 32 * TS, TS, Bn + tj * 32 * TS, TS, 64, lane);
#pragma unroll
                for (int j = 0; j < 16; ++j) { const int r = ti * 32 + ACC_ROW(j, lane); ARB[r * TS + s] = (s <= r) ? f2bf(rb[j]) : (bf16_t)0; } }
              { f32x16 rk = mma_ll(zero16(), Rn + ti * 32 * TS, TS, Kn + tj * 32 * TS, TS, 64, lane);
#pragma unroll
                for (int j = 0; j < 16; ++j) { const int r = ti * 32 + ACC_ROW(j, lane); ARK[r * TS + s] = (s <= r) ? f2bf(rk[j]) : (bf16_t)0; } } }
          f32x16 ab = mma_ll(zero16(), At + ti * 32 * TS, TS, Bn + tj * 32 * TS, TS, 64, lane);
          __syncthreads();
#pragma unroll
          for (int q = 0; q < 4; ++q) { const int r0 = ti * 32 + 8 * q + 4 * (lane >> 5);
              *(LAS f32x4*)(AAB + s * FS + r0) = (f32x4){ab[4 * q], ab[4 * q + 1], ab[4 * q + 2], ab[4 * q + 3]}; } }
        __syncthreads();
        const bf16_t* S0 = SEN + (size_t)item * 4096;
        { f32x16 x = mma_ll(zero16(), AK + ti * 32 * TS, TS, VT + tj * 32 * TS, TS, 64, lane);
          if (PASS == 3) x = mma_lg(x, At + ti * 32 * TS, TS, S0 + (size_t)(tj * 32) * 64, 64, 64, lane);
          __syncthreads();
          const int v = tj * 32 + (lane & 31);
#pragma unroll
          for (int j = 0; j < 16; ++j) { const int r = ti * 32 + ACC_ROW(j, lane); XF[r * FS + v] = x[j]; } }
        __syncthreads();
        PROF_T1(4, ws);
        PROF_T0(1);
        { const int aw0 = (PASS == 1) ? 2 * (team_gid & 1) : (team_gid & 1);
          const bool active = (PASS == 1) ? (wq == aw0 || wq == aw0 + 1) : (wq == aw0);
          if (active) {
              const bool BF = (PASS == 1 && wq == aw0);
#pragma unroll 1
              for (int b16 = 0; b16 < 64; b16 += 16) {
                  float acc[16];
#pragma unroll
                  for (int i = 0; i < 16; ++i) acc[i] = BF ? bf2f(At[(b16 + i) * TS + lane]) : XF[(b16 + i) * FS + lane];
#pragma unroll 4
                  for (int s = 0; s < b16; ++s) { const float us = BF ? bf2f(At[s * TS + lane]) : XF[s * FS + lane];
                      const LAS f32x4* cp = (const LAS f32x4*)(AAB + s * FS + b16);
                      const f32x4 c0 = cp[0], c1 = cp[1], c2 = cp[2], c3 = cp[3];
#pragma unroll
                      for (int e = 0; e < 4; ++e) { acc[e] += c0[e] * us; acc[4 + e] += c1[e] * us; acc[8 + e] += c2[e] * us; acc[12 + e] += c3[e] * us; } }
#pragma unroll
                  for (int j = 0; j < 15; ++j) { float uj = acc[j];
                      if (BF) uj = bf2f(f2bf(uj));
                      const LAS float* cp = AAB + (b16 + j) * FS + b16;
#pragma unroll
                      for (int i = j + 1; i < 16; ++i) acc[i] += cp[i] * uj;
                      __builtin_amdgcn_sched_barrier(0); }
#pragma unroll
                  for (int i = 0; i < 16; ++i) { if (BF) At[(b16 + i) * TS + lane] = f2bf(acc[i]); else XF[(b16 + i) * FS + lane] = acc[i]; }
              } }
          __syncthreads();
          float ux[16]; u32x4 w0, w1;
#pragma unroll
          for (int e = 0; e < 16; ++e) ux[e] = XF[t * FS + seg * 16 + e];
          if (PASS == 1) { w0 = *(const LAS u32x4*)(At + t * TS + seg * 16); w1 = *(const LAS u32x4*)(At + t * TS + seg * 16 + 8); }
          __syncthreads();
          if (PASS == 1) { float wx[16]; unpack8(w0, wx); unpack8(w1, wx + 8);
#pragma unroll
              for (int e = 0; e < 16; ++e) { UT0[(seg * 16 + e) * TS + t] = f2bf(wx[e]); UT1[(seg * 16 + e) * TS + t] = f2bf(ux[e]); } }
          else {
#pragma unroll
              for (int e = 0; e < 16; ++e) UT0[(seg * 16 + e) * TS + t] = f2bf(ux[e]); } }
        __syncthreads();
        PROF_T1(1, ws);
        PROF_T0(5);
        if (PASS == 1) {
            f32x16 m = mma_ll(zero16(), UT0 + ti * 32 * TS, TS, BT + tj * 32 * TS, TS, 64, lane);
            f32x16 n = mma_ll(zero16(), BT + ti * 32 * TS, TS, UT1 + tj * 32 * TS, TS, 64, lane);
            n = mma_ll(n, KT + ti * 32 * TS, TS, VT + tj * 32 * TS, TS, 64, lane);
            const int col = tj * 32 + (lane & 31); const float ptc = PT[col];
            bf16_t* mg = MtG + (size_t)item * 4096; bf16_t* ng = NG + (size_t)item * 4096;
#pragma unroll
            for (int q = 0; q < 4; ++q) { const int r0 = ti * 32 + 8 * q + 4 * (lane >> 5); float mv[4], nv[4];
#pragma unroll
                for (int e = 0; e < 4; ++e) { mv[e] = (m[4 * q + e] + ((r0 + e) == col ? 1.0f : 0.0f)) * ptc; nv[e] = n[4 * q + e] * PT[r0 + e]; }
                { u32x2 w; w.x = pack2(mv[0], mv[1]); w.y = pack2(mv[2], mv[3]);
                  const int mo = col >> 4, li = col & 15, ks = r0 >> 5, rem = r0 & 31, hi = rem >> 4, g = (rem & 15) >> 2;
                  *(u32x2*)(mg + (((mo * 2 + ks) * 64 + g * 16 + li) * 8 + 4 * hi)) = w; }
                { u32x2 w; w.x = pack2(nv[0], nv[1]); w.y = pack2(nv[2], nv[3]);
                  const int slv = col >> 4, li = col & 15, mo = r0 >> 4, g = (r0 & 15) >> 2;
                  *(u32x2*)(ng + (((slv * 4 + mo) * 64 + g * 16 + li) * 4)) = w; } }
        } else {
            f32x16 y = mma_lg(zero16(), Rn + ti * 32 * TS, TS, S0 + (size_t)(tj * 32) * 64, 64, 64, lane);
            y = mma_ll(y, ARB + ti * 32 * TS, TS, UT0 + tj * 32 * TS, TS, 64, lane);
            y = mma_ll(y, ARK + ti * 32 * TS, TS, VT + tj * 32 * TS, TS, 64, lane);
            __syncthreads();
            const int v = tj * 32 + (lane & 31);
#pragma unroll
            for (int j = 0; j < 16; ++j) { const int r = ti * 32 + ACC_ROW(j, lane); XF[r * FS + v] = y[j]; }
            __syncthreads();
            float yv[16]; float sm = 0.f;
#pragma unroll
            for (int e = 0; e < 16; ++e) { yv[e] = XF[t * FS + seg * 16 + e]; sm += yv[e]; }
            sm += shx(sm, 1); sm += shx(sm, 2);
            const float mean = sm * (1.0f / 64.0f); float vs = 0.f;
#pragma unroll
            for (int e = 0; e < 16; ++e) { const float d = yv[e] - mean; vs += d * d; }
            vs += shx(vs, 1); vs += shx(vs, 2);
            const float rs = rsqrtf(vs * (1.0f / 64.0f) + 64e-5f);
            const int co = 64 * h + seg * 16; const float* lg = p.in(22) + layer * 512 + co; const float* lb = p.in(23) + layer * 512 + co;
            float o[16], gg[16];
            ld16_lerp(crow + C_G + co, prow ? prow + C_G + co : nullptr, mu + (C_G - C_RW) + co, gg);
#pragma unroll
            for (int e = 0; e < 16; ++e) { const float yn = (yv[e] - mean) * rs * lg[e] + lb[e] + bonus * vv[e]; o[e] = ((DBG_DBL & 2) ? 2.f : 1.f) * yn * siluf_(gg[e]); }
#if DBG_NORW
#pragma unroll
            for (int e = 0; e < 16; ++e) o[e] = 0.f;
#endif
            st16_g(MIX + (size_t)gt * MIXW + 512 + co, o);
        }
        __syncthreads();
        PROF_T1(5, ws);
    }
}


#if DBG_SLOWR
__device__ __forceinline__ float xs_lerp(const bf16_t* crow, const bf16_t* prow, int col, float mu) {
    const float c = bf2f(crow[col]); const float q = prow ? bf2f(prow[col]) : 0.f; return c + (q - c) * mu; }
__device__ __forceinline__ void rwkv_slow(const Ctx& p, int layer, LAS unsigned char* lds) {
    if (blockIdx.x >= 8 || ltid() >= 64) return;
    unsigned char* ws = p.wsp(); const bf16_t* PROJ = (const bf16_t*)(ws + OFF_PROJ); bf16_t* MIX = (bf16_t*)(p.outp() + OUT_MIX); bf16_t* VF = (bf16_t*)(ws + OFF_VF);
    const int h = blockIdx.x, c = ltid() & 63, ch = 64 * h + c;
    const float* mu = p.in(14) + layer * 2176; const float* wup = p.in(15) + (size_t)layer * 64 * 512; const float* aup = p.in(17) + (size_t)layer * 64 * 512; const float* vup = p.in(25);
    const float w0 = p.in(16)[layer * 512 + ch], a0 = p.in(18)[layer * 512 + ch], kkw = p.in(19)[layer * 512 + ch], kaw = p.in(20)[layer * 512 + ch], rkw = p.in(21)[layer * 512 + ch];
    const float lng = p.in(22)[layer * 512 + ch], lnb = p.in(23)[layer * 512 + ch]; const float v0 = layer ? p.in(26)[ch] : 0.f;
    const float mu_wd = mu[1536 + c], mu_ad = mu[1600 + c], mu_r = mu[ch], mu_k = mu[512 + ch], mu_v = mu[1024 + ch], mu_g = mu[1664 + ch]; const float mu_vd = (layer && c < 32) ? p.in(24)[c] : 0.f;
    LAS float* T1 = (LAS float*)lds;
    LAS float* VEC = (LAS float*)(lds + 1024);
    LAS float* SL = (LAS float*)(lds + 4096);
#pragma unroll 1
    for (int k = 0; k < 64; ++k) SL[k * 64 + c] = 0.f;
#pragma unroll 1
    for (int t = 0; t < L_; ++t) {
        const bf16_t* crow = PROJ + (size_t)t * PSTR; const bf16_t* prow = t > 0 ? crow - PSTR : nullptr;
        T1[c] = tanhf(xs_lerp(crow, prow, C_WD + c, mu_wd)); T1[64 + c] = xs_lerp(crow, prow, C_AD + c, mu_ad); T1[128 + c] = (layer && c < 32) ? xs_lerp(crow, prow, C_VD + c, mu_vd) : 0.f;
        asm volatile("s_waitcnt lgkmcnt(0)" ::: "memory");
        float wl = 0.f, al = 0.f, vl = 0.f;
#pragma unroll 2
        for (int j = 0; j < 64; ++j) { const float* wr = wup + j * 512; const float* ar = aup + j * 512; wl += T1[j] * wr[ch]; al += T1[64 + j] * ar[ch]; }
        if (layer) {
#pragma unroll 2
            for (int j = 0; j < 32; ++j) { const float* vr = vup + j * 512; vl += T1[128 + j] * vr[ch]; } }
        const float wlog = -softplusf_(-(w0 + wl)) - 0.5f; const float dec = __expf(-__expf(wlog)); const float a = sigmoidf_(a0 + al);
        const float r = xs_lerp(crow, prow, C_R + ch, mu_r), k = xs_lerp(crow, prow, C_K + ch, mu_k), g = xs_lerp(crow, prow, C_G + ch, mu_g); float v = xs_lerp(crow, prow, C_V + ch, mu_v);
        if (layer) { const float vf = bf2f(VF[(size_t)t * 512 + ch]); v = v + (vf - v) * sigmoidf_(v0 + vl); } else VF[(size_t)t * 512 + ch] = f2bf(v);
        float kk = k * kkw; float ss = kk * kk;
#pragma unroll
        for (int o = 32; o > 0; o >>= 1) ss += shx(ss, o);
        kk = kk / fmaxf(sqrtf(ss), 1e-12f);
        const float k2 = k * (1.0f + (a - 1.0f) * kaw);
        __builtin_amdgcn_wave_barrier();
        VEC[c] = r; VEC[64 + c] = dec; VEC[128 + c] = k2; VEC[192 + c] = -kk; VEC[256 + c] = kk * a;
        asm volatile("s_waitcnt lgkmcnt(0)" ::: "memory");
        float sa = 0.f;
#pragma unroll 4
        for (int k = 0; k < 64; ++k) sa += SL[k * 64 + c] * VEC[192 + k];
        float y = 0.f;
#pragma unroll 4
        for (int k = 0; k < 64; ++k) { const float s = SL[k * 64 + c] * VEC[64 + k] + sa * VEC[256 + k] + v * VEC[128 + k]; SL[k * 64 + c] = s; y += s * VEC[k]; }
        float sm = y, bo = r * k2 * rkw;
#pragma unroll
        for (int o = 32; o > 0; o >>= 1) { sm += shx(sm, o); bo += shx(bo, o); }
        const float mean = sm * (1.0f / 64.0f); float vs = (y - mean) * (y - mean);
#pragma unroll
        for (int o = 32; o > 0; o >>= 1) vs += shx(vs, o);
        const float yn = (y - mean) * rsqrtf(vs * (1.0f / 64.0f) + 64e-5f) * lng + lnb + bo * v;
        MIX[(size_t)t * MIXW + 512 + ch] = f2bf(yn * siluf_(g));
        __builtin_amdgcn_wave_barrier();
    }
}
#endif

__device__ __forceinline__ void rwkv_scan(const Ctx& p, int wid, LAS unsigned char* wl) {
    const int lane = ltid() & 63; const int h = wid >> 2, sl = wid & 3, v0 = sl * 16, g = lane >> 4, li = lane & 15;
    const bf16_t* MtG = (const bf16_t*)(p.wsp() + OFF_R1); const bf16_t* NG = MtG + (size_t)2048 * 4096;
    bf16_t* SEN = (bf16_t*)(p.outp() + OUT_SEN);
    f32x4 acc[4];
#pragma unroll
    for (int n = 0; n < 4; ++n) acc[n] = (f32x4){0.f, 0.f, 0.f, 0.f};
    u32x4 aA[8], aB[8], aC[8], aD[8]; u32x2 nA[4], nB[4], nC[4], nD[4];
#define SCAN_LOAD(A_, N_, cc) do { const int c_ = (cc) < 256 ? (cc) : 255; const size_t ib_ = (size_t)(c_ * 8 + h) * 4096; \
        _Pragma("unroll") for (int mo = 0; mo < 4; ++mo) { \
            N_[mo] = *(const u32x2*)(NG + ib_ + ((sl * 4 + mo) * 64 + lane) * 4); \
            A_[2 * mo] = *(const u32x4*)(MtG + ib_ + ((mo * 2) * 64 + lane) * 8); \
            A_[2 * mo + 1] = *(const u32x4*)(MtG + ib_ + ((mo * 2 + 1) * 64 + lane) * 8); } } while (0)
#define SCAN_STEP(A_, N_, cc) do { const size_t ib_ = (size_t)((cc) * 8 + h) * 4096; \
        u32x2 pk[4]; \
        _Pragma("unroll") for (int mt = 0; mt < 4; ++mt) { pk[mt].x = pack2(acc[mt][0], acc[mt][1]); pk[mt].y = pack2(acc[mt][2], acc[mt][3]); \
            *(u32x2*)(SEN + ib_ + (v0 + li) * 64 + 16 * mt + 4 * g) = pk[mt]; } \
        const bf16x8 b0 = __builtin_bit_cast(bf16x8, ((u32x4){pk[0].x, pk[0].y, pk[1].x, pk[1].y})); \
        const bf16x8 b1 = __builtin_bit_cast(bf16x8, ((u32x4){pk[2].x, pk[2].y, pk[3].x, pk[3].y})); \
        _Pragma("unroll") for (int mo = 0; mo < 4; ++mo) { f32x4 na; \
            na[0] = __uint_as_float(N_[mo].x << 16); na[1] = __uint_as_float(N_[mo].x & 0xffff0000u); na[2] = __uint_as_float(N_[mo].y << 16); na[3] = __uint_as_float(N_[mo].y & 0xffff0000u); \
            na = __builtin_amdgcn_mfma_f32_16x16x32_bf16(__builtin_bit_cast(bf16x8, A_[2 * mo]), b0, na, 0, 0, 0); \
            acc[mo] = __builtin_amdgcn_mfma_f32_16x16x32_bf16(__builtin_bit_cast(bf16x8, A_[2 * mo + 1]), b1, na, 0, 0, 0); } } while (0)
    SCAN_LOAD(aA, nA, 0); SCAN_LOAD(aB, nB, 1); SCAN_LOAD(aC, nC, 2);
#pragma unroll 1
    for (int c = 0; c < 256; c += 4) {
        SCAN_LOAD(aD, nD, c + 3); SCAN_STEP(aA, nA, c);
        SCAN_LOAD(aA, nA, c + 4); SCAN_STEP(aB, nB, c + 1);
        SCAN_LOAD(aB, nB, c + 5); SCAN_STEP(aC, nC, c + 2);
        SCAN_LOAD(aC, nC, c + 6); SCAN_STEP(aD, nD, c + 3);
    }
#undef SCAN_LOAD
#undef SCAN_STEP
}

constexpr int BS_ = 136;
__device__ __forceinline__ void conv16(const bf16_t* PROJ, int gt, int ch0, const float* cw  , const float* cb, float* o) {
#pragma unroll
    for (int e = 0; e < 16; ++e) o[e] = cb[ch0 + e];
#pragma unroll
    for (int j = 0; j < 4; ++j) { const int ts = gt - 3 + j;
        if (ts >= 0) { float x[16]; ld16(PROJ + (size_t)ts * PSTR + C_X + ch0, x);
#pragma unroll
            for (int e = 0; e < 16; ++e) o[e] += cw[j * 1024 + ch0 + e] * x[e]; } }
#pragma unroll
    for (int e = 0; e < 16; ++e) o[e] = siluf_(o[e]);
}
template <int PASS>
__device__ __forceinline__ void mamba_pass(const Ctx& p, int layer, LAS unsigned char* tl, LAS unsigned char* lds, int team) {
    unsigned char* ws = p.wsp();
    const int tt0 = ltid() & 255;
    const bf16_t* PROJ = (const bf16_t*)(ws + OFF_PROJ);
    bf16_t* STG = (bf16_t*)(ws + OFF_R1);
    float* GDEC = (float*)(ws + OFF_GDEC);
    bf16_t* MIX = (bf16_t*)(p.outp() + OUT_MIX);
    const float* cw = p.in(27) + layer * 4096; const float* cb = p.in(28) + layer * 1024;
    LAS float* CS = (LAS float*)(tl + 73728);
    LAS float* DTv = (LAS float*)(tl + 73728 + 1024);
    LAS float* SSQX = (LAS float*)(lds + PTAB_OFF + 512);
    LAS bf16_t* XT = (LAS bf16_t*)(tl + 0); LAS bf16_t* BT = (LAS bf16_t*)(tl + 9216);
    LAS bf16_t* Bn = (LAS bf16_t*)(tl + 9216); LAS bf16_t* Cn = (LAS bf16_t*)(tl + 26624); LAS bf16_t* SC = (LAS bf16_t*)(tl + 44032); LAS float* YF = (LAS float*)(tl + 53248);
    for (int c = blockIdx.x; c < 256; c += gridDim.x) {
        const int gq = team, t0 = c * 64;
        int tt = tt0; asm volatile("" : "+v"(tt));
        const int wq = __builtin_amdgcn_readfirstlane(tt >> 6), lane = tt & 63, ti = wq >> 1, tj = wq & 1;
        const int t = tt >> 2, seg = tt & 3, gt = t0 + t;
        { const int h = 4 * gq + wq; const float dtr = bf2f(PROJ[(size_t)(t0 + lane) * PSTR + C_DT + h]) + p.in(29)[layer * 8 + h];
          const float dt = softplusf_(dtr); float da = -dt * __expf(p.in(30)[layer * 8 + h]);
#pragma unroll
          for (int o = 1; o < 64; o <<= 1) { const float n = shup(da, o); if (lane >= o) da += n; }
          CS[wq * 64 + lane] = da; DTv[wq * 64 + lane] = dt; }
#pragma unroll
        for (int hh = 0; hh < 2; ++hh) { const int n0 = hh * 64 + seg * 16; float bv[16];
            conv16(PROJ, gt, 512 + 128 * gq + n0, cw, cb, bv);
            if (PASS == 1) {
#pragma unroll
                for (int e = 0; e < 16; ++e) BT[(n0 + e) * TS + t] = f2bf(bv[e]);
            } else { st16_lds(Bn + t * BS_ + n0, bv); conv16(PROJ, gt, 768 + 128 * gq + n0, cw, cb, bv); st16_lds(Cn + t * BS_ + n0, bv); } }
        __syncthreads();
        float ssq_acc = 0.f; u32x4 hold[4][2];
#pragma unroll
        for (int h4 = 0; h4 < 4; ++h4) {
            const int h = 4 * gq + h4; const LAS float* cs = CS + h4 * 64;
            float xv[16];
            { const float cs63 = cs[63], cst = cs[t], dt = DTv[h4 * 64 + t];
              conv16(PROJ, gt, 64 * h + seg * 16, cw, cb, xv);
              const float f = (PASS == 1) ? dt * __expf(cs63 - cst) : dt;
#pragma unroll
              for (int e = 0; e < 16; ++e) XT[(seg * 16 + e) * TS + t] = f2bf(xv[e] * f);
              if (PASS == 1 && tt == 0) GDEC[c * 8 + h] = __expf(cs63); }
            __syncthreads();
            if (PASS == 1) {
                bf16_t* sg = STG + (size_t)(c * 8 + h) * 8192;
#pragma unroll
                for (int nn = 0; nn < 2; ++nn) { const int nt = tj * 2 + nn;
                    f32x16 a = mma_ll(zero16(), XT + ti * 32 * TS, TS, BT + nt * 32 * TS, TS, 64, lane);
                    const int n = nt * 32 + (lane & 31);
#pragma unroll
                    for (int j = 0; j < 16; ++j) { const int r = ti * 32 + ACC_ROW(j, lane); sg[r * 128 + n] = f2bf(a[j]); } }
            } else {
                float z[16]; ld16(PROJ + (size_t)gt * PSTR + C_Z + 64 * h + seg * 16, z);
                bf16x8 sfr[8];
                { const bf16_t* sp = STG + (size_t)(c * 8 + h) * 8192 + (size_t)(tj * 32 + (lane & 31)) * 128 + 8 * (lane >> 5);
#pragma unroll
                  for (int k = 0; k < 8; ++k) sfr[k] = *(const bf16x8*)(sp + 16 * k); }
                { f32x16 sc = mma_ll(zero16(), Cn + ti * 32 * BS_, BS_, Bn + tj * 32 * BS_, BS_, 128, lane);
                  const int s = tj * 32 + (lane & 31); const float css = cs[s];
#pragma unroll
                  for (int j = 0; j < 16; ++j) { const int r = ti * 32 + ACC_ROW(j, lane); SC[r * TS + s] = (s <= r) ? f2bf(sc[j] * __expf(cs[r] - css)) : (bf16_t)0; } }
                __syncthreads();
                { f32x16 yd = mma_ll(zero16(), SC + ti * 32 * TS, TS, XT + tj * 32 * TS, TS, 64, lane);
                  f32x16 yo = zero16();
                  { const LAS bf16_t* pa = Cn + (ti * 32 + (lane & 31)) * BS_ + 8 * (lane >> 5);
#pragma unroll
                    for (int k = 0; k < 8; ++k) yo = __builtin_amdgcn_mfma_f32_32x32x16_bf16(*(const LAS bf16x8*)(pa + 16 * k), sfr[k], yo, 0, 0, 0); }
                  const int pp = tj * 32 + (lane & 31);
#pragma unroll
                  for (int j = 0; j < 16; ++j) { const int r = ti * 32 + ACC_ROW(j, lane); YF[r * FS + pp] = yd[j] + __expf(cs[r]) * yo[j]; } }
                __syncthreads();
                { const float dsk = p.in(31)[layer * 8 + h]; float o[16]; float ss = 0.f;
#pragma unroll
                  for (int e = 0; e < 16; ++e) { const float y = YF[t * FS + seg * 16 + e] + xv[e] * dsk; o[e] = (DBG_ZERO & 4) ? 0.f : y * siluf_(z[e]); ss += o[e] * o[e]; }
                  ss += shx(ss, 1); ss += shx(ss, 2);
                  ssq_acc += ss; hold[h4][0] = pack8(o); hold[h4][1] = pack8(o + 8); }
            }
            __syncthreads();
        }
        if (PASS == 3) {
            if (seg == 0) SSQX[team * 64 + t] = ssq_acc;
            __syncthreads();
            const float rs = rsqrtf((SSQX[t] + SSQX[64 + t]) * (1.0f / 512.0f) + 1e-5f);
#pragma unroll
            for (int h4 = 0; h4 < 4; ++h4) { float o[16]; unpack8(hold[h4][0], o); unpack8(hold[h4][1], o + 8);
#pragma unroll
                for (int e = 0; e < 16; ++e) o[e] *= rs;
                st16_g(MIX + (size_t)gt * MIXW + 1024 + 64 * (4 * gq + h4) + seg * 16, o); }
            __syncthreads();
        }
    }
}
__device__ __forceinline__ void mamba_scan(const Ctx& p, int gtid) {
    bf16_t* STG = (bf16_t*)(p.wsp() + OFF_R1); const float* GDEC = (const float*)(p.wsp() + OFF_GDEC);
    const int h = gtid >> 13, pn = gtid & 8191; float st = 0.f;
#pragma unroll 1
    for (int c0 = 0; c0 < 256; c0 += 32) { float sv[32], gv[32];
#pragma unroll
        for (int j = 0; j < 32; ++j) { sv[j] = bf2f(STG[(size_t)((c0 + j) * 8 + h) * 8192 + pn]); gv[j] = GDEC[(c0 + j) * 8 + h]; }
#pragma unroll
        for (int j = 0; j < 32; ++j) { STG[(size_t)((c0 + j) * 8 + h) * 8192 + pn] = f2bf(st); st = st * gv[j] + sv[j]; } }
}


#if DBG_SLOWM
constexpr size_t OFF_DBGDT = WS_END + 4096;
__device__ __forceinline__ void mamba_slow_prep(const Ctx& p, int layer) {
    unsigned char* ws = p.wsp(); const bf16_t* PROJ = (const bf16_t*)(ws + OFF_PROJ); bf16_t* XBC = (bf16_t*)(ws + OFF_R1); float* DT = (float*)(ws + OFF_DBGDT);
    const float* cw = p.in(27) + layer * 4096; const float* cb = p.in(28) + layer * 1024;
    for (int i = blockIdx.x * 512 + ltid(); i < L_ * 64; i += gridDim.x * 512) { const int t = i >> 6, ch0 = (i & 63) * 16; float o[16];
        conv16(PROJ, t, ch0, cw, cb, o); st16_g(XBC + (size_t)t * 1024 + ch0, o);
        if ((i & 63) < 8) { const int h = i & 63; DT[t * 8 + h] = softplusf_(bf2f(PROJ[(size_t)t * PSTR + C_DT + h]) + p.in(29)[layer * 8 + h]); } }
}
__device__ __forceinline__ void mamba_slow_seq(const Ctx& p, int layer) {
    if (blockIdx.x >= 8 || ltid() >= 64) return;
    unsigned char* ws = p.wsp(); const bf16_t* PROJ = (const bf16_t*)(ws + OFF_PROJ); const bf16_t* XBC = (const bf16_t*)(ws + OFF_R1); const float* DT = (const float*)(ws + OFF_DBGDT);
    bf16_t* MIX = (bf16_t*)(p.outp() + OUT_MIX); float* SSQ = (float*)(ws + OFF_SSQ);
    const int h = blockIdx.x, pp = ltid() & 63, gq = h >> 2;
    const float A = -__expf(p.in(30)[layer * 8 + h]), dsk = p.in(31)[layer * 8 + h];
    float st[128];
#pragma unroll
    for (int n = 0; n < 128; ++n) st[n] = 0.f;
#pragma unroll 1
    for (int t = 0; t < L_; ++t) {
        const float dt = DT[t * 8 + h]; const float dec = __expf(dt * A);
        const float x = bf2f(XBC[(size_t)t * 1024 + 64 * h + pp]); const float xdt = x * dt; float y = 0.f;
        const bf16_t* Bp = XBC + (size_t)t * 1024 + 512 + 128 * gq; const bf16_t* Cp = XBC + (size_t)t * 1024 + 768 + 128 * gq;
#pragma unroll
        for (int n8 = 0; n8 < 128; n8 += 8) { float bv[8], cv[8]; unpack8(*(const u32x4*)(Bp + n8), bv); unpack8(*(const u32x4*)(Cp + n8), cv);
#pragma unroll
            for (int e = 0; e < 8; ++e) { st[n8 + e] = st[n8 + e] * dec + xdt * bv[e]; y += cv[e] * st[n8 + e]; } }
        const float z = bf2f(PROJ[(size_t)t * PSTR + C_Z + 64 * h + pp]);
        const float yg = (y + x * dsk) * siluf_(z); float ss = yg * yg;
#pragma unroll
        for (int o = 32; o > 0; o >>= 1) ss += shx(ss, o);
        if (pp == 0) SSQ[t * 8 + h] = ss;
        MIX[(size_t)t * MIXW + 1024 + 64 * h + pp] = f2bf(yg);
    }
}
#endif


#if DBG_SLOWS
__device__ __forceinline__ void s5_slow(const Ctx& p, int layer) {
    if (blockIdx.x >= 32 || ltid() >= 64) return;
    unsigned char* ws = p.wsp(); const bf16_t* PROJ = (const bf16_t*)(ws + OFF_PROJ); bf16_t* YB = (bf16_t*)(p.outp() + OUT_SEN);
    const int g = blockIdx.x, pp = ltid() & 63, gp = g * 64 + pp;
    const float dt = expf(p.in(4)[layer * 32 + g]); const float ar = p.in(5)[layer * 2048 + gp], ai = p.in(6)[layer * 2048 + gp];
    const float mag = expf(dt * ar); const float abr = mag * cosf(dt * ai), abi = mag * sinf(dt * ai);
    const float den = ar * ar + ai * ai; const float fre = ((abr - 1.0f) * ar + abi * ai) / den, fim = (abi * ar - (abr - 1.0f) * ai) / den;
    float bre[16], bim[16], cre[16], cim[16];
#pragma unroll
    for (int c = 0; c < 16; ++c) { const float br = p.in(7)[(size_t)layer * 32768 + gp * 16 + c], bi = p.in(8)[(size_t)layer * 32768 + gp * 16 + c];
        bre[c] = fre * br - fim * bi; bim[c] = fre * bi + fim * br;
        cre[c] = p.in(9)[(size_t)layer * 32768 + g * 1024 + c * 64 + pp]; cim[c] = p.in(10)[(size_t)layer * 32768 + g * 1024 + c * 64 + pp]; }
    const float dsk = pp < 16 ? p.in(11)[layer * 512 + g * 16 + pp] : 0.f;
    float sr = 0.f, si = 0.f;
#pragma unroll 1
    for (int t = 0; t < L_; ++t) {
        float u[16]; ld16(PROJ + (size_t)t * PSTR + C_S5U + 16 * g, u);
        float br = 0.f, bi = 0.f;
#pragma unroll
        for (int c = 0; c < 16; ++c) { br += u[c] * bre[c]; bi += u[c] * bim[c]; }
        const float nr = abr * sr - abi * si + br, ni = abr * si + abi * sr + bi; sr = nr; si = ni;
        float mine = 0.f;
#pragma unroll
        for (int c = 0; c < 16; ++c) { float v = cre[c] * sr - cim[c] * si;
#pragma unroll
            for (int o = 32; o > 0; o >>= 1) v += shx(v, o);
            if (pp == c) mine = v + dsk * u[c]; }
        if (pp < 16) { const float ge = 0.5f * mine * (1.0f + tanhf(0.7978845608f * (mine + 0.044715f * mine * mine * mine))); YB[(size_t)t * 512 + 16 * g + pp] = f2bf(ge); }
    }
}
#endif

template <int PASS>
__device__ __forceinline__ void s5_pass(const Ctx& p, int layer, LAS unsigned char* lds, int gw0, int nw) {
    unsigned char* ws = p.wsp();
    const int tid0 = ltid();
    bf16_t* PROJ = (bf16_t*)(ws + OFF_PROJ);
    const bf16_t* BB = (const bf16_t*)(ws + OFF_BB + lofs(layer)); const bf16_t* CC = (const bf16_t*)(ws + OFF_CC + lofs(layer));
    const float2* AB = (const float2*)(ws + OFF_ABAR + lofs(layer)); float2* S5E = (float2*)(ws + OFF_S5E);
    const int wib = __builtin_amdgcn_readfirstlane(tid0 >> 6);
    LAS bf16_t* BU = (LAS bf16_t*)(lds + wib * 17408);
    for (int wi0 = gw0; wi0 < 8192; wi0 += nw) {
        const bool valid = (wi0 + wib) < 8192; const int wi = valid ? wi0 + wib : 0;
        int tt = tid0; asm volatile("" : "+v"(tt));
        const int lane = tt & 63;
        const int c = wi >> 5, g = wi & 31, t0 = c * 64;
#pragma unroll
        for (int tr = 0; tr < 2; ++tr) {
            const bf16x8 a = *(const bf16x8*)(PROJ + (size_t)(t0 + tr * 32 + (lane & 31)) * PSTR + C_S5U + 16 * g + 8 * (lane >> 5));
#pragma unroll
            for (int qt = 0; qt < 4; ++qt) {
                const bf16x8 b = *(const bf16x8*)(BB + (size_t)(g * 128 + qt * 32 + (lane & 31)) * 16 + 8 * (lane >> 5));
                f32x16 r = __builtin_amdgcn_mfma_f32_32x32x16_bf16(a, b, zero16(), 0, 0, 0);
#pragma unroll
                for (int j = 0; j < 16; ++j) BU[(tr * 32 + ACC_ROW(j, lane)) * BS_ + qt * 32 + (lane & 31)] = f2bf(r[j]); } }
        __syncthreads();
        { const float2 ab = AB[g * 64 + lane]; float sr = 0.f, si = 0.f;
          if (PASS == 3) { const float2 s0 = S5E[(size_t)(c * 32 + g) * 64 + lane]; sr = s0.x; si = s0.y; }
#pragma unroll 1
          for (int tb = 0; tb < 64; tb += 8) { float brv[8], biv[8];
#pragma unroll
              for (int j = 0; j < 8; ++j) { brv[j] = bf2f(BU[(tb + j) * BS_ + lane]); biv[j] = bf2f(BU[(tb + j) * BS_ + 64 + lane]); }
#pragma unroll
              for (int j = 0; j < 8; ++j) { const float nr = ab.x * sr - ab.y * si + brv[j], ni = ab.x * si + ab.y * sr + biv[j]; sr = nr; si = ni;
                  if (PASS == 3) { BU[(tb + j) * BS_ + lane] = f2bf(sr); BU[(tb + j) * BS_ + 64 + lane] = f2bf(si); } } }
          if (PASS == 1 && valid) S5E[(size_t)(c * 32 + g) * 64 + lane] = make_float2(sr, si); }
        __syncthreads();
        if (PASS == 3) {
            const int cc = lane & 31;
#pragma unroll
            for (int tr = 0; tr < 2; ++tr) {
                f32x16 y = mma_lg(zero16(), BU + tr * 32 * BS_, BS_, CC + (size_t)(g * 32) * 128, 128, 128, lane);
                if (cc < 16 && valid) { const float dsk = p.in(11)[layer * 512 + g * 16 + cc];
#pragma unroll
                    for (int j = 0; j < 16; ++j) { const int gt = t0 + tr * 32 + ACC_ROW(j, lane);
                        bf16_t* up = PROJ + (size_t)gt * PSTR + C_S5U + 16 * g + cc;
                        const float v = y[j] + dsk * bf2f(*up);
                        *up = f2bf(0.5f * v * (1.0f + tanh_fast_(0.7978845608f * (v + 0.044715f * v * v * v)))); } } }
        }
        __syncthreads();
    }
}
__device__ __forceinline__ void s5_scan(const Ctx& p, int layer, int gtid) {
    float2* S5E = (float2*)(p.wsp() + OFF_S5E); const float2 a = ((const float2*)(p.wsp() + OFF_AB64 + lofs(layer)))[gtid];
    float sr = 0.f, si = 0.f;
#pragma unroll 1
    for (int c0 = 0; c0 < 256; c0 += 16) { float2 ev[16];
#pragma unroll
        for (int j = 0; j < 16; ++j) ev[j] = S5E[(size_t)(c0 + j) * 2048 + gtid];
#pragma unroll
        for (int j = 0; j < 16; ++j) { S5E[(size_t)(c0 + j) * 2048 + gtid] = make_float2(sr, si);
            const float nr = a.x * sr - a.y * si + ev[j].x, ni = a.x * si + a.y * sr + ev[j].y; sr = nr; si = ni; } }
}

static_assert(WS_END <= (size_t)256 * 1024 * 1024, "workspace overflow");
__global__ void __launch_bounds__(512, 2) mega_fwd(Params pa) {
    extern __shared__ __attribute__((aligned(16))) unsigned char smem[];
    LAS unsigned char* lds = (LAS unsigned char*)smem;
    cg::grid_group grid = cg::this_grid();
    const int team = __builtin_amdgcn_readfirstlane(ltid() >> 8), team_gid = blockIdx.x * 2 + team, nteams = gridDim.x * 2;
    LAS unsigned char* tl = lds + team * TEAM_LDS;
    if (ltid() == 0) { LAS unsigned long long* tw = (LAS unsigned long long*)(lds + PTAB_OFF);
#pragma unroll
        for (int i = 0; i < 35; ++i) tw[i] = (unsigned long long)pa.in[i]; }
    if (ltid() == 0) { ((LAS unsigned*)(lds + PTAB_OFF + 288))[0] = 0u; ((LAS unsigned*)(lds + PTAB_OFF + 288))[1] = 0u; }
    __syncthreads();
    const XcdBarrier xbar = xcd_barrier_post((unsigned*)(pa.ws + OFF_BAR), (volatile LAS unsigned*)(lds + PTAB_OFF + 288));
#if DBG_PROF
    if (blockIdx.x == 0 && ltid() == 0) { unsigned long long* a_ = (unsigned long long*)(pa.ws + OFF_PROF); a_[0] = 0ull; a_[1] = wall_clock64(); }
#endif
    Ctx p; p.tab = (LAS const unsigned*)(lds + PTAB_OFF); p.out = pa.out; p.ws = pa.ws;
    unsigned char* ws = p.ws;
    bf16_t* PROJ = (bf16_t*)(ws + OFF_PROJ); bf16_t* MIX = (bf16_t*)((unsigned char*)p.out + OUT_MIX);
    unsigned* gbar = (unsigned*)(ws + OFF_BAR); unsigned seam = 0;
#if USE_CG_SYNC
#define GSYNC() grid.sync()
#else
#define GSYNC() xcd_barrier(xbar)
#endif
    if (pa.ws == nullptr) grid.sync();
    unsigned* s5flag = (unsigned*)(ws + OFF_S5FLAG);
    for (int layer = 0; layer < 2; ++layer) {
        if (layer == 0) prep_weights(p, 0, lds, (int)blockIdx.x, (int)gridDim.x);
        prep_hb(p, layer);
        GSYNC();
        { pg8::Gemm g{(const bf16_t*)(ws + OFF_R1), (const bf16_t*)(ws + OFF_WIN), L_, NPAD, 1024, 1024}; pg8::StaticOrder S; S.init(L_, NPAD, (int)gridDim.x, (int)blockIdx.x);
          EpiProj E{PROJ}; pg8::gemm_phase<EpiProj, pg8::StaticOrder, false>(lds, g, S, E, nullptr); }
        GSYNC();
        rwkv_pass<1>(p, layer, tl, team_gid, nteams);
        s5_pass<1>(p, layer, lds, (int)blockIdx.x * 8, (int)gridDim.x * 8);
        GSYNC();
        if (blockIdx.x < 32) { if (ltid() < 64) rwkv_scan(p, blockIdx.x, lds); }
        else if (blockIdx.x < 36) s5_scan(p, layer, ((int)blockIdx.x - 32) * 512 + ltid());
        else if (layer == 0) prep_weights(p, 1, lds, (int)blockIdx.x - 36, (int)gridDim.x - 36);
        GSYNC();
        rwkv_pass<3>(p, layer, tl, team_gid, nteams);
        s5_pass<3>(p, layer, lds, (int)blockIdx.x * 8, (int)gridDim.x * 8);
        mamba_pass<1>(p, layer, tl, lds, team);
        GSYNC();
        if (blockIdx.x < 128) mamba_scan(p, (int)blockIdx.x * 512 + ltid());
        else { pg8::Gemm g{(const bf16_t*)(ws + OFF_PROJ) + C_S5U, (const bf16_t*)(ws + OFF_WGLU + lofs(layer)), L_, 512, 512, PSTR}; pg8::StaticOrder S; S.init(L_, 512, 128, (int)blockIdx.x - 128);
          EpiGlu E{MIX, PROJ, PROJ, p.in(13) + layer * 512}; pg8::gemm_phase<EpiGlu, pg8::StaticOrder, false>(lds, g, S, E, nullptr); }
        GSYNC();
        mamba_pass<3>(p, layer, tl, lds, team);
        GSYNC();
        { pg8::Gemm g{MIX, (const bf16_t*)(ws + OFF_WOUT + lofs(layer)), L_, 1024, 1536, 1536}; pg8::StaticOrder S; S.init(L_, 1024, (int)gridDim.x, (int)blockIdx.x);
          EpiD0 E{(bf16_t*)(ws + (layer == 0 ? OFF_D0 : OFF_PROJ))}; pg8::gemm_phase<EpiD0, pg8::StaticOrder, false>(lds, g, S, E, nullptr); }
        GSYNC();
    }
#if DBG_PROBE
    phase_probe(p);
    GSYNC();
#endif
    for (int xs_ = 0; xs_ < DBG_XSYNC; ++xs_) GSYNC();
    phase_final(p);
}

extern "C" void kernel_launch(void* const* d_in, const int* in_sizes, int n_in, void* d_out, int out_size, void* d_ws, size_t ws_size, hipStream_t stream) {
    static int grid_blocks = 0;
    if (!grid_blocks) {
        int dev = 0, cus = 0, per_cu = 0;
        hipGetDevice(&dev);
        hipDeviceGetAttribute(&cus, hipDeviceAttributeMultiprocessorCount, dev);
        hipFuncSetAttribute((const void*)mega_fwd, hipFuncAttributeMaxDynamicSharedMemorySize, LDS_BYTES);
        hipOccupancyMaxActiveBlocksPerMultiprocessor(&per_cu, (const void*)mega_fwd, 512, LDS_BYTES);
        int cap = cus * per_cu;
        grid_blocks = cap >= 256 ? 256 : -1;
        if (grid_blocks < 0) fprintf(stderr, "kernel_launch: resident capacity %d x %d < 256 workgroups\n", cus, per_cu);
        if (n_in != 35 || ws_size < ALT_END + (size_t)(1 << 20)) { fprintf(stderr, "kernel_launch: unexpected n_in %d / ws %zu\n", n_in, ws_size); grid_blocks = -1; }
    }
    if (grid_blocks < 0) return;
    (void)hipMemsetAsync((unsigned char*)d_ws + OFF_BAR, 0, 16384 + 256, stream);
    Params p{};
    for (int i = 0; i < 35; ++i) p.in[i] = (const float*)d_in[i];
    p.out = (float*)d_out; p.ws = (unsigned char*)d_ws;
    void* args[] = {&p};
    hipError_t e = hipLaunchCooperativeKernel((const void*)mega_fwd, dim3(grid_blocks), dim3(512), args, LDS_BYTES, stream);
    if (e != hipSuccess) fprintf(stderr, "cooperative launch failed: %s\n", hipGetErrorString(e));
}
```

```cpp
#include <hip/hip_runtime.h>
#include <hip/hip_cooperative_groups.h>
#include <cstdio>
namespace cg = cooperative_groups;
namespace pg8 {
#define PG8_LAS __attribute__((address_space(3)))
typedef unsigned short bf16_t;
typedef short bf16x8 __attribute__((ext_vector_type(8)));
typedef float f32x4 __attribute__((ext_vector_type(4)));
typedef unsigned u32x4 __attribute__((ext_vector_type(4)));
constexpr int BM = 256, BK = 64, HALF = 128, HTB = HALF * BK * 2  , STAGE_BYTES = 8 * HTB, NXCD = 8, WGM = 8;

__host__ __device__ __forceinline__ int lds_byte(int r, int c) { const int st = (r >> 4) * 2 + (c >> 5), rr = r & 15, cc = c & 31, ob = rr * 64 + cc * 2; return st * 1024 + (ob ^ (((ob >> 9) & 1) << 5)); }
__host__ __device__ __forceinline__ void stage_rc(int b, int& R, int& C) { const int st = b / 1024, sb = b % 1024, swz = sb ^ (((sb >> 9) & 1) << 5); R = (st >> 1) * 16 + swz / 64; C = (st & 1) * 32 + (swz % 64) / 2; }
__host__ __device__ __forceinline__ int perm32(int rho) { const int n = rho >> 4, i = rho & 15; return 8 * (i >> 2) + 4 * n + (i & 3); }

struct Unit { int pm, pn; };
struct Gemm { const bf16_t* A; const bf16_t* Bt; int M, N, K; int lda; };

struct StaticOrder {
    int nM, nN, nwg, G, c;
    __host__ __device__ void init(int M, int N, int G_, int c_) { nM = M / BM; nN = N / BM; nwg = nM * nN; G = G_; c = c_; }
    __host__ __device__ bool next(int i, Unit& u) const {
        const long L = (long)i * G + c; if (L >= nwg) return false;
        int wgid = (int)L; { const int q = nwg / NXCD, r = nwg % NXCD, xcd = wgid % NXCD, off = wgid / NXCD; wgid = (xcd < r ? xcd * (q + 1) : r * (q + 1) + (xcd - r) * q) + off; }
        const int nig = WGM * nN, gid = wgid / nig, fm = gid * WGM, gsz = (nM - fm) < WGM ? (nM - fm) : WGM;
        u.pm = fm + ((wgid % nig) % gsz); u.pn = (wgid % nig) / gsz; return true;
    }
    __device__ __forceinline__ void a_ready(const Unit&) const {}
    __device__ __forceinline__ void done(const Unit&) const {}
};
__device__ __forceinline__ unsigned cvt_pk_bf16(float lo, float hi) { unsigned r; asm volatile("v_cvt_pk_bf16_f32 %0, %1, %2" : "=v"(r) : "v"(lo), "v"(hi)); return r; }
template <class Epi, class Sched, bool STAMP = false>
__device__ __forceinline__ void gemm_phase(PG8_LAS unsigned char* lds, const Gemm g, const Sched& S, const Epi& E, unsigned long long* stamps) {
    int tid_raw = threadIdx.x; asm volatile("" : "+v"(tid_raw)); const int tid = tid_raw, wid = __builtin_amdgcn_readfirstlane(tid >> 6), lane = tid & 63, wr = wid >> 2, wc = wid & 3, fr = lane & 15, fq = lane >> 4;
    const int K = g.K, nt = K / BK;
    int ts_lo = 0, ts_hi = 0, nts = 0; const unsigned long long rt_entry = STAMP ? (unsigned long long)0ull : 0ull;
#define PG8_STAMP() do { if (STAMP && wid == 0 && nts < 64) { const unsigned long long _c = (unsigned long long)clock64(); \
        ts_lo = (lane == nts) ? (int)(unsigned)_c : ts_lo; ts_hi = (lane == nts) ? (int)(unsigned)(_c >> 32) : ts_hi; ++nts; } } while (0)
    PG8_STAMP();
    unsigned voffA[2], voffB[2];
#pragma unroll
    for (int i = 0; i < 2; ++i) { int R, C; stage_rc(tid * 16 + i * 8192, R, C); const int Rb = Epi::PERM ? ((R & ~31) + perm32(R & 31)) : R;
        voffA[i] = (unsigned)(R * g.lda + C) * 2u; voffB[i] = (unsigned)(Rb * K + C) * 2u; }
    const size_t kstep = (size_t)(BK * 2);
    const size_t hstep = (size_t)HALF * K * 2, hstepA = (size_t)HALF * g.lda * 2;
    const size_t tstep = 2 * hstep, tstepA = 2 * hstepA;
    const unsigned ldsw = (unsigned)wid * 1024u;
    const int aoff = lds_byte(wr * 64 + fr, fq * 8), boff = lds_byte(wc * 32 + fr, fq * 8);
#define PG8_SA(b, h) (((b) * 2 + (h)) * HTB)
#define PG8_SB(b, h) ((4 + (b) * 2 + (h)) * HTB)
#define PG8_STAGE(bufoff, gbase, voff) do { _Pragma("unroll") for (int _i = 0; _i < 2; ++_i) \
        __builtin_amdgcn_global_load_lds((const unsigned*)((const char*)(gbase) + (voff)[_i]), (PG8_LAS unsigned*)(lds + (bufoff) + ldsw + _i * 8192), 16, 0, 0); } while (0)
#define PG8_LDA(dst, b, h) do { _Pragma("unroll") for (int m = 0; m < 4; ++m) _Pragma("unroll") for (int k = 0; k < 2; ++k) dst[m][k] = *(const PG8_LAS bf16x8*)(lds + PG8_SA(b, h) + aoff + m * 2048 + k * 1024); } while (0)
#define PG8_LDB(dst, b, h) do { _Pragma("unroll") for (int n = 0; n < 2; ++n) _Pragma("unroll") for (int k = 0; k < 2; ++k) dst[n][k] = *(const PG8_LAS bf16x8*)(lds + PG8_SB(b, h) + boff + n * 2048 + k * 1024); } while (0)
#define PG8_MMA(ai, bj, At, Bt) do { __builtin_amdgcn_s_setprio(1); _Pragma("unroll") for (int m = 0; m < 4; ++m) _Pragma("unroll") for (int n = 0; n < 2; ++n) _Pragma("unroll") for (int k = 0; k < 2; ++k) \
        acc[ai][bj][m][n] = __builtin_amdgcn_mfma_f32_16x16x32_bf16(Bt[n][k], At[m][k], acc[ai][bj][m][n], 0, 0, 0); __builtin_amdgcn_s_setprio(0); } while (0)
#define PG8_WAIT_V(n) asm volatile("s_waitcnt vmcnt(" #n ")" ::: "memory")
#define PG8_WAIT_L(n) asm volatile("s_waitcnt lgkmcnt(" #n ")" ::: "memory")
#define PG8_BAR __builtin_amdgcn_s_barrier()
#define PG8_SCHED __builtin_amdgcn_sched_barrier(0)
    Unit cur, nxt; int ui = 0;
    if (!S.next(0, cur)) return;
    f32x4 acc[2][2][4][2];
#pragma unroll
    for (int a = 0; a < 2; ++a)
#pragma unroll
        for (int b = 0; b < 2; ++b)
#pragma unroll
            for (int m = 0; m < 4; ++m)
#pragma unroll
                for (int n = 0; n < 2; ++n) acc[a][b][m][n] = (f32x4){0.f, 0.f, 0.f, 0.f};
    bf16x8 At[4][2], B0[2][2], B1[2][2];
    const char* cA = (const char*)g.A + (size_t)cur.pm * tstepA; const char* cB = (const char*)g.Bt + (size_t)cur.pn * tstep;
    S.a_ready(cur);
    PG8_STAGE(PG8_SB(0, 0), cB, voffB); PG8_STAGE(PG8_SA(0, 0), cA, voffA); PG8_STAGE(PG8_SB(0, 1), cB + hstep, voffB); PG8_STAGE(PG8_SA(0, 1), cA + hstepA, voffA);
    if (wr == 1) PG8_BAR;
    PG8_WAIT_V(4); PG8_BAR;
    PG8_STAGE(PG8_SB(1, 0), cB + kstep, voffB); PG8_STAGE(PG8_SA(1, 0), cA + kstep, voffA); PG8_STAGE(PG8_SB(1, 1), cB + hstep + kstep, voffB);
    PG8_WAIT_V(6); PG8_BAR;
    PG8_STAMP();
    for (;;) {
        const bool has_next = S.next(ui + 1, nxt);
        const char* nA = has_next ? (const char*)g.A + (size_t)nxt.pm * tstepA : cA; const char* nB = has_next ? (const char*)g.Bt + (size_t)nxt.pn * tstep : cB;
        for (int t = 0; t < nt; t += 2) {
            const bool last = (t == nt - 2);
            const char* a1 = cA + (size_t)(t + 1) * kstep;
            const char* a2 = last ? nA : cA + (size_t)(t + 2) * kstep; const char* b2 = last ? nB : cB + (size_t)(t + 2) * kstep;
            const char* a3 = a2 + kstep; const char* b3 = b2 + kstep;
            if (last && has_next) S.a_ready(nxt);
            PG8_LDB(B0, 0, 0); PG8_SCHED; PG8_LDA(At, 0, 0); PG8_STAGE(PG8_SA(1, 1), a1 + hstepA, voffA);
            PG8_WAIT_L(8); PG8_BAR; PG8_WAIT_L(0); PG8_MMA(0, 0, At, B0); PG8_BAR; PG8_SCHED;
            PG8_LDB(B1, 0, 1); PG8_STAGE(PG8_SB(0, 0), b2, voffB);
            PG8_BAR; PG8_WAIT_L(0); PG8_MMA(0, 1, At, B1); PG8_BAR;
            PG8_LDA(At, 0, 1); PG8_STAGE(PG8_SA(0, 0), a2, voffA);
            PG8_BAR; PG8_WAIT_L(0); PG8_MMA(1, 0, At, B0); PG8_BAR; PG8_SCHED;
            PG8_STAGE(PG8_SB(0, 1), b2 + hstep, voffB);
            PG8_WAIT_V(6); PG8_BAR; PG8_MMA(1, 1, At, B1); PG8_BAR;
            PG8_LDB(B0, 1, 0); PG8_SCHED; PG8_LDA(At, 1, 0); PG8_STAGE(PG8_SA(0, 1), a2 + hstepA, voffA);
            PG8_WAIT_L(8); PG8_BAR; PG8_WAIT_L(0); PG8_MMA(0, 0, At, B0); PG8_BAR; PG8_SCHED;
            PG8_LDB(B1, 1, 1); PG8_STAGE(PG8_SB(1, 0), b3, voffB);
            PG8_BAR; PG8_WAIT_L(0); PG8_MMA(0, 1, At, B1); PG8_BAR;
            PG8_LDA(At, 1, 1); PG8_STAGE(PG8_SA(1, 0), a3, voffA);
            PG8_BAR; PG8_WAIT_L(0); PG8_MMA(1, 0, At, B0); PG8_BAR; PG8_SCHED;
            PG8_STAGE(PG8_SB(1, 1), b3 + hstep, voffB);
            PG8_WAIT_V(6); PG8_BAR; PG8_MMA(1, 1, At, B1); PG8_BAR;
        }
        PG8_STAMP();
        if constexpr (!Epi::AFTER_DRAIN) { E(acc, cur, wr, wc, fr, fq); S.done(cur); }
        PG8_STAMP();
        if (!has_next) break;
#pragma unroll
        for (int a = 0; a < 2; ++a)
#pragma unroll
            for (int b = 0; b < 2; ++b)
#pragma unroll
                for (int m = 0; m < 4; ++m)
#pragma unroll
                    for (int n = 0; n < 2; ++n) acc[a][b][m][n] = (f32x4){0.f, 0.f, 0.f, 0.f};
        cur = nxt; cA = nA; cB = nB; ++ui;
    }
    PG8_WAIT_V(0);
    if (wr == 0) PG8_BAR;
    PG8_BAR;
    if constexpr (Epi::AFTER_DRAIN) { E.fused(acc, cur, wr, wc, fr, fq, lds, wid, lane); S.done(cur); }
    PG8_STAMP();
    if (STAMP && wid == 0) { stamps[lane] = lane < nts ? (((unsigned long long)(unsigned)ts_hi << 32) | (unsigned)ts_lo) : 0ull;
        if (lane == 62) stamps[62] = rt_entry; if (lane == 63) stamps[63] = (unsigned long long)0ull; }
#undef PG8_STAMP
#undef PG8_SA
#undef PG8_SB
#undef PG8_STAGE
#undef PG8_LDA
#undef PG8_LDB
#undef PG8_MMA
#undef PG8_WAIT_V
#undef PG8_WAIT_L
#undef PG8_BAR
#undef PG8_SCHED
}
}

#define LAS __attribute__((address_space(3)))
#ifndef DBG_ZERO
#define DBG_ZERO 0
#endif
#define DBG_NORW ((DBG_ZERO >> 1) & 1)
#ifndef DBG_RWS0
#define DBG_RWS0 0
#endif
#ifndef DBG_SLOWM
#define DBG_SLOWM 0
#endif
#ifndef DBG_SLOWR
#define DBG_SLOWR 0
#endif
#ifndef DBG_SLOWS
#define DBG_SLOWS 0
#endif
#ifndef DBG_DUP
#define DBG_DUP 0
#endif
#ifndef DBG_XSYNC
#define DBG_XSYNC 0
#endif
#ifndef USE_CG_SYNC
#define USE_CG_SYNC 0
#endif
#ifndef DBG_PROF
#define DBG_PROF 0
#endif
#ifndef DBG_DBL
#define DBG_DBL 0
#endif
#ifndef DBG_PROBE
#define DBG_PROBE 0
#endif
#ifndef DBG_MASK
#define DBG_MASK 0xfff
#endif
#ifndef DBG_FINAL
#define DBG_FINAL 2
#endif
typedef unsigned short bf16_t;
typedef short bf16x8 __attribute__((ext_vector_type(8)));
typedef float f32x4 __attribute__((ext_vector_type(4)));
typedef float f32x16 __attribute__((ext_vector_type(16)));
typedef unsigned u32x4 __attribute__((ext_vector_type(4)));
typedef unsigned u32x2 __attribute__((ext_vector_type(2)));

constexpr int L_ = 16384, D_ = 1024, NCH = 256;
constexpr int PW = 4744, PSTR = 4800, NPAD = 4864;
constexpr int C_S5U = 0, C_S5G = 512, C_RW = 1024, C_R = 1024, C_K = 1536, C_V = 2048, C_WD = 2560, C_AD = 2624, C_G = 2688;
constexpr int C_X = 3200, C_B = 3712, C_C = 3968, C_DT = 4224, C_Z = 4232, C_VD = 4744;
constexpr int MIXW = 1536;
constexpr int TEAM_LDS = 75776;
constexpr int LDS_BYTES = 2 * TEAM_LDS + 1024;

constexpr size_t OFF_PROJ = 0;
constexpr size_t OFF_R1   = OFF_PROJ + (size_t)L_ * PSTR * 2;
constexpr size_t OFF_D0   = OFF_R1 + (size_t)L_ * 1024 * 2;
constexpr size_t OFF_VF   = OFF_D0 + (size_t)L_ * 1024 * 2;
constexpr size_t OFF_WIN  = OFF_VF + (size_t)L_ * 512 * 2;
constexpr size_t OFF_WOUT = OFF_WIN + (size_t)NPAD * 1024 * 2;
constexpr size_t OFF_WGLU = OFF_WOUT + (size_t)1024 * 1536 * 2;
constexpr size_t OFF_WUP  = OFF_WGLU + (size_t)512 * 512 * 2;
constexpr size_t OFF_AUP  = OFF_WUP + 512 * 64 * 2;
constexpr size_t OFF_VUP  = OFF_AUP + 512 * 64 * 2;
constexpr size_t OFF_BB   = OFF_VUP + 512 * 64 * 2;
constexpr size_t OFF_CC   = OFF_BB + 32 * 128 * 16 * 2;
constexpr size_t OFF_ABAR = OFF_CC + 32 * 32 * 128 * 2;
constexpr size_t OFF_AB64 = OFF_ABAR + 2048 * 8;
constexpr size_t OFF_GDEC = OFF_AB64 + 2048 * 8;
constexpr size_t OFF_SSQ  = OFF_GDEC + 2048 * 4;
constexpr size_t OFF_S5E  = OFF_SSQ + (size_t)L_ * 8 * 4;
constexpr size_t OFF_BAR  = OFF_S5E + (size_t)256 * 2048 * 8;
constexpr size_t OFF_PROF = OFF_BAR + 16384;
constexpr size_t OFF_S5FLAG = OFF_PROF + 128;
constexpr size_t WS_END   = OFF_PROF + 256;
constexpr size_t OUT_MIX = 0, OUT_SEN = (size_t)L_ * MIXW * 2;

__device__ __forceinline__ int ltid() { int t = threadIdx.x; asm volatile("" : "+v"(t)); return t; }
__device__ __forceinline__ int lane_id_opaque() { int l = __builtin_amdgcn_mbcnt_hi(-1, __builtin_amdgcn_mbcnt_lo(-1, 0)); asm volatile("" : "+v"(l)); return l; }
__device__ __forceinline__ float shx(float v, int m) { return __int_as_float(__builtin_amdgcn_ds_bpermute((lane_id_opaque() ^ m) << 2, __float_as_int(v))); }
__device__ __forceinline__ float shup(float v, int d) { const int l = lane_id_opaque(); return __int_as_float(__builtin_amdgcn_ds_bpermute((l >= d ? l - d : l) << 2, __float_as_int(v))); }
#define XB_TMO      128
#define XB_XCNT(j)  (256  + 64 * (j))
#define XB_XSUB(j)  (1280 + 64 * (j))
#define XB_XGEN(j)  (2304 + 64 * (j))
#define XB_TOP      3328
#define XB_TOPGEN   3392
#define XCD_BAR_WORDS 3456
#define XB_SPIN_CAP (1u << 18)

__device__ __forceinline__ unsigned xb_ld(unsigned* p)              { return __hip_atomic_load(p, __ATOMIC_RELAXED, __HIP_MEMORY_SCOPE_AGENT); }
__device__ __forceinline__ unsigned xb_add(unsigned* p, unsigned v) { return __hip_atomic_fetch_add(p, v, __ATOMIC_RELAXED, __HIP_MEMORY_SCOPE_AGENT); }
__device__ __forceinline__ unsigned xb_xcc_id() { return (unsigned)__builtin_amdgcn_s_getreg((3 << 11) | 20) & 0xFu; }
#define XB_SPIN(cond, bar) do { unsigned _sp = 0; while (cond) { __builtin_amdgcn_s_sleep(1); \
    if ((++_sp & 255u) == 0u) { if (xb_ld(&(bar)[XB_TMO])) break; if (_sp > XB_SPIN_CAP) { atomicAdd(&(bar)[XB_TMO], 1u); break; } } } } while (0)

struct XcdBarrier {
    unsigned* bar; unsigned x;
    volatile LAS unsigned* st;
};

__device__ __forceinline__ XcdBarrier xcd_barrier_post(unsigned* bar, volatile LAS unsigned* st) {
    XcdBarrier b; b.bar = bar; b.x = xb_xcc_id(); b.st = st;
    if (threadIdx.x == 0) (void)xb_add(&bar[XB_XCNT(b.x)], 1u);
    return b;
}
__device__ __forceinline__ void xcd_barrier_complete(unsigned* bar, unsigned x, unsigned& nloc, unsigned& nx) {
    const unsigned G = gridDim.x * gridDim.y * gridDim.z;
    unsigned sum, cnt, mine, sp = 0u;
    for (;;) {
        sum = 0u; cnt = 0u; mine = 0u;
#pragma unroll
        for (unsigned j = 0; j < 16; ++j) { const unsigned c = xb_ld(&bar[XB_XCNT(j)]); sum += c; cnt += (c > 0u) ? 1u : 0u; mine = (j == x) ? c : mine; }
        if (sum == G) break;
        __builtin_amdgcn_s_sleep(1);
        if ((++sp & 255u) == 0u) { if (xb_ld(&bar[XB_TMO])) break; if (sp > XB_SPIN_CAP) { atomicAdd(&bar[XB_TMO], 1u); break; } }
    }
    nloc = mine > 0u ? mine : 1u; nx = cnt > 0u ? cnt : 1u;
}

__device__ __forceinline__ void xcd_barrier(const XcdBarrier& b) {
    asm volatile("s_waitcnt vmcnt(0)" ::: "memory");
    __syncthreads();
    if (threadIdx.x == 0) {
        unsigned* bar = b.bar;
        __builtin_amdgcn_s_waitcnt(0);
        unsigned nloc = b.st[0], nx = b.st[1];
        if (nloc == 0u) { xcd_barrier_complete(bar, b.x, nloc, nx); b.st[0] = nloc; b.st[1] = nx; }
        const unsigned old = xb_add(&bar[XB_XSUB(b.x)], 1u);
        const unsigned gen = old / nloc;
        if (old + 1u == (gen + 1u) * nloc) {
            __builtin_amdgcn_fence(__ATOMIC_RELEASE, "agent");
            asm volatile("s_waitcnt vmcnt(0)" ::: "memory");
            const unsigned og = xb_add(&bar[XB_TOP], 1u);
            const unsigned tg = og / nx;
            if (og + 1u == (tg + 1u) * nx) xb_add(&bar[XB_TOPGEN], 1u);
            else XB_SPIN(xb_ld(&bar[XB_TOPGEN]) == tg, bar);
            __builtin_amdgcn_fence(__ATOMIC_ACQUIRE, "agent");
            xb_add(&bar[XB_XGEN(b.x)], 1u);
            asm volatile("s_waitcnt vmcnt(0)" ::: "memory");
        } else {
            XB_SPIN(xb_ld(&bar[XB_XGEN(b.x)]) == gen, bar);
            __builtin_amdgcn_fence(__ATOMIC_ACQUIRE, "agent");
            asm volatile("s_waitcnt vmcnt(0)" ::: "memory");
        }
    }
    __syncthreads();
}

__device__ __forceinline__ void grid_bar(unsigned* cnt, unsigned target) {
    __threadfence();
    __syncthreads();
    if (ltid() == 0) {
        __hip_atomic_fetch_add(cnt, 1u, __ATOMIC_RELEASE, __HIP_MEMORY_SCOPE_AGENT);
        while (__hip_atomic_load(cnt, __ATOMIC_ACQUIRE, __HIP_MEMORY_SCOPE_AGENT) < target) __builtin_amdgcn_s_sleep(2);
    }
    __syncthreads();
    __threadfence();
}
#if DBG_PROF
#define PROF_T0(id) unsigned long long prof_t0_##id = 0; if (DBG_PROF == (id) && blockIdx.x == 0 && ltid() == 0) prof_t0_##id = wall_clock64()
#define PROF_T1(id, wsptr) do { if (DBG_PROF == (id) && blockIdx.x == 0 && ltid() == 0) { unsigned long long* a_ = (unsigned long long*)((wsptr) + OFF_PROF); a_[0] += wall_clock64() - prof_t0_##id; } } while (0)
#else
#define PROF_T0(id) do {} while (0)
#define PROF_T1(id, wsptr) do {} while (0)
#endif
constexpr size_t ALT_OFF = ((WS_END + 255) / 256) * 256 - OFF_WOUT;
constexpr size_t ALT_END = OFF_GDEC + ALT_OFF;
__device__ __forceinline__ size_t lofs(int layer) { return layer ? ALT_OFF : (size_t)0; }
struct Params { const float* in[35]; float* out; unsigned char* ws; };
constexpr int PTAB_OFF = 2 * 75776;
struct Ctx { LAS const unsigned* tab; float* out; unsigned char* ws;
    __device__ __forceinline__ unsigned char* wsp() const { unsigned char* w = ws; asm volatile("" : "+s"(w)); return w; }
    __device__ __forceinline__ unsigned char* outp() const { unsigned char* w = (unsigned char*)out; asm volatile("" : "+s"(w)); return w; }
    __device__ __forceinline__ const float* in(int k) const { int off = 2 * k; asm volatile("" : "+s"(off)); LAS const unsigned* q = tab + off;
        const unsigned lo = __builtin_amdgcn_readfirstlane(q[0]), hi = __builtin_amdgcn_readfirstlane(q[1]);
        return (const float*)(((unsigned long long)hi << 32) | lo); } };

typedef __bf16 bf16x2_n __attribute__((ext_vector_type(2)));
typedef float f32x2_n __attribute__((ext_vector_type(2)));
__device__ __forceinline__ bf16_t f2bf(float f) { const __bf16 b = (__bf16)f; return __builtin_bit_cast(unsigned short, b); }
__device__ __forceinline__ float bf2f(unsigned b) { return __uint_as_float(b << 16); }
__device__ __forceinline__ unsigned pack2(float lo, float hi) { const f32x2_n v = {lo, hi}; const bf16x2_n b = __builtin_convertvector(v, bf16x2_n); return __builtin_bit_cast(unsigned, b); }
__device__ __forceinline__ float sigmoidf_(float x) { return __builtin_amdgcn_rcpf(1.0f + __expf(-x)); }
__device__ __forceinline__ float siluf_(float x) { return x * __builtin_amdgcn_rcpf(1.0f + __expf(-x)); }
__device__ __forceinline__ float softplusf_(float z) { return z > 20.f ? z : log1pf(__expf(z)); }
__device__ __forceinline__ float softplus_pos_(float z) { return z > 20.f ? z : __logf(1.0f + __expf(z)); }
__device__ __forceinline__ float tanh_fast_(float x) { return 1.0f - 2.0f * __builtin_amdgcn_rcpf(1.0f + __expf(2.0f * x)); }
__device__ __forceinline__ void unpack8(u32x4 v, float* o) {
#pragma unroll
    for (int i = 0; i < 4; ++i) { o[2 * i] = __uint_as_float(v[i] << 16); o[2 * i + 1] = __uint_as_float(v[i] & 0xffff0000u); }
}
__device__ __forceinline__ u32x4 pack8(const float* o) { u32x4 v; v.x = pack2(o[0], o[1]); v.y = pack2(o[2], o[3]); v.z = pack2(o[4], o[5]); v.w = pack2(o[6], o[7]); return v; }
__device__ __forceinline__ void ld16(const bf16_t* p, float* o) { u32x4 a = *(const u32x4*)p, b = *(const u32x4*)(p + 8); unpack8(a, o); unpack8(b, o + 8); }
__device__ __forceinline__ void ld16_lerp(const bf16_t* crow, const bf16_t* prow, const float* mu, float* o) {
    float c[16], q[16]; ld16(crow, c);
    if (prow) ld16(prow, q); else {
#pragma unroll
        for (int i = 0; i < 16; ++i) q[i] = 0.f; }
#pragma unroll
    for (int i = 0; i < 16; ++i) o[i] = c[i] + (q[i] - c[i]) * mu[i];
}
__device__ __forceinline__ void ld8_lerp(const bf16_t* crow, const bf16_t* prow, const float* mu, float* o) {
    float c[8], q[8]; unpack8(*(const u32x4*)crow, c);
    if (prow) unpack8(*(const u32x4*)prow, q); else {
#pragma unroll
        for (int i = 0; i < 8; ++i) q[i] = 0.f; }
#pragma unroll
    for (int i = 0; i < 8; ++i) o[i] = c[i] + (q[i] - c[i]) * mu[i];
}
__device__ __forceinline__ void st16_lds(LAS bf16_t* p, const float* o) { *(LAS u32x4*)p = pack8(o); *(LAS u32x4*)(p + 8) = pack8(o + 8); }
__device__ __forceinline__ void st16_g(bf16_t* p, const float* o) { *(u32x4*)p = pack8(o); *(u32x4*)(p + 8) = pack8(o + 8); }

__device__ __forceinline__ f32x16 mma_ll(f32x16 acc, const LAS bf16_t* A, int lda, const LAS bf16_t* B, int ldb, int K, int lane) {
    const LAS bf16_t* pa = A + (lane & 31) * lda + 8 * (lane >> 5);
    const LAS bf16_t* pb = B + (lane & 31) * ldb + 8 * (lane >> 5);
#pragma unroll 4
    for (int k = 0; k < K; k += 16) { bf16x8 a = *(const LAS bf16x8*)(pa + k); bf16x8 b = *(const LAS bf16x8*)(pb + k); acc = __builtin_amdgcn_mfma_f32_32x32x16_bf16(a, b, acc, 0, 0, 0); }
    return acc;
}
__device__ __forceinline__ f32x16 mma_lg(f32x16 acc, const LAS bf16_t* A, int lda, const bf16_t* B, int ldb, int K, int lane) {
    const LAS bf16_t* pa = A + (lane & 31) * lda + 8 * (lane >> 5);
    const bf16_t* pb = B + (size_t)(lane & 31) * ldb + 8 * (lane >> 5);
#pragma unroll 4
    for (int k = 0; k < K; k += 16) { bf16x8 a = *(const LAS bf16x8*)(pa + k); bf16x8 b = *(const bf16x8*)(pb + k); acc = __builtin_amdgcn_mfma_f32_32x32x16_bf16(a, b, acc, 0, 0, 0); }
    return acc;
}
__device__ __forceinline__ f32x16 mma_gg(f32x16 acc, const bf16_t* A, int lda, const bf16_t* B, int ldb, int K, int lane) {
    const bf16_t* pa = A + (size_t)(lane & 31) * lda + 8 * (lane >> 5);
    const bf16_t* pb = B + (size_t)(lane & 31) * ldb + 8 * (lane >> 5);
#pragma unroll 4
    for (int k = 0; k < K; k += 16) { bf16x8 a = *(const bf16x8*)(pa + k); bf16x8 b = *(const bf16x8*)(pb + k); acc = __builtin_amdgcn_mfma_f32_32x32x16_bf16(a, b, acc, 0, 0, 0); }
    return acc;
}
#define ACC_ROW(j, lane) (((j) & 3) + 8 * ((j) >> 2) + 4 * ((lane) >> 5))
__device__ __forceinline__ f32x16 zero16() { f32x16 z;
#pragma unroll
    for (int i = 0; i < 16; ++i) z[i] = 0.f; return z; }

using pg8::Unit; using pg8::BM; using pg8::HALF;
struct EpiProj {
    static constexpr bool PERM = true, AFTER_DRAIN = false;
    bf16_t* O;
    __device__ __forceinline__ void operator()(const f32x4 (&acc)[2][2][4][2], const Unit& u, int wr, int wc, int fr, int fq) const {
        const int row0 = u.pm * BM + wr * 64 + fr, col0 = u.pn * BM + wc * 32 + 8 * fq;
#pragma unroll
        for (int ai = 0; ai < 2; ++ai)
#pragma unroll
            for (int m = 0; m < 4; ++m) { bf16_t* rowp = O + (size_t)(row0 + ai * HALF + m * 16) * PSTR + col0;
#pragma unroll
                for (int bj = 0; bj < 2; ++bj) { const f32x4 v0 = acc[ai][bj][m][0], v1 = acc[ai][bj][m][1];
                    u32x4 w; w.x = pack2(v0[0], v0[1]); w.y = pack2(v0[2], v0[3]); w.z = pack2(v1[0], v1[1]); w.w = pack2(v1[2], v1[3]);
                    if (col0 + bj * HALF < PSTR) *(u32x4*)(rowp + bj * HALF) = w; } }
    }
};
struct EpiD0 {
    static constexpr bool PERM = true, AFTER_DRAIN = false;
    bf16_t* O;
    __device__ __forceinline__ void operator()(const f32x4 (&acc)[2][2][4][2], const Unit& u, int wr, int wc, int fr, int fq) const {
        const int row0 = u.pm * BM + wr * 64 + fr, col0 = u.pn * BM + wc * 32 + 8 * fq;
#pragma unroll
        for (int ai = 0; ai < 2; ++ai)
#pragma unroll
            for (int m = 0; m < 4; ++m) { bf16_t* rowp = O + (size_t)(row0 + ai * HALF + m * 16) * 1024 + col0;
#pragma unroll
                for (int bj = 0; bj < 2; ++bj) { const f32x4 v0 = acc[ai][bj][m][0], v1 = acc[ai][bj][m][1];
                    u32x4 w; w.x = pack2(v0[0], v0[1]); w.y = pack2(v0[2], v0[3]); w.z = pack2(v1[0], v1[1]); w.w = pack2(v1[2], v1[3]);
                    *(u32x4*)(rowp + bj * HALF) = w; } }
    }
};
struct EpiH2 {
    static constexpr bool PERM = false, AFTER_DRAIN = false;
    float* O;
    __device__ __forceinline__ void operator()(const f32x4 (&acc)[2][2][4][2], const Unit& u, int wr, int wc, int fr, int fq) const {
        const int row0 = u.pm * BM + wr * 64 + fr, col0 = u.pn * BM + wc * 32 + 4 * fq;
#pragma unroll
        for (int ai = 0; ai < 2; ++ai)
#pragma unroll
            for (int m = 0; m < 4; ++m) { float* rowp = O + (size_t)(row0 + ai * HALF + m * 16) * 1024 + col0;
#pragma unroll
                for (int bj = 0; bj < 2; ++bj)
#pragma unroll
                    for (int n = 0; n < 2; ++n) *(f32x4*)(rowp + bj * HALF + n * 16) = acc[ai][bj][m][n]; }
    }
};
struct EpiGlu {
    static constexpr bool PERM = true, AFTER_DRAIN = false;
    bf16_t* MIX; const bf16_t* Y; const bf16_t* PROJ; const float* bias;
    __device__ __forceinline__ void operator()(const f32x4 (&acc)[2][2][4][2], const Unit& u, int wr, int wc, int fr, int fq) const {
        const int row0 = u.pm * BM + wr * 64 + fr, col0 = u.pn * BM + wc * 32 + 8 * fq;
#pragma unroll
        for (int ai = 0; ai < 2; ++ai)
#pragma unroll
            for (int m = 0; m < 4; ++m) { const int row = row0 + ai * HALF + m * 16;
#pragma unroll
                for (int bj = 0; bj < 2; ++bj) { const int col = col0 + bj * HALF;
                    float z[8], y[8], g[8], o[8];
                    const f32x4 v0 = acc[ai][bj][m][0], v1 = acc[ai][bj][m][1];
#pragma unroll
                    for (int e = 0; e < 4; ++e) { z[e] = v0[e] + bias[col + e]; z[4 + e] = v1[e] + bias[col + 4 + e]; }
                    unpack8(*(const u32x4*)(Y + (size_t)row * PSTR + C_S5U + col), y);
                    unpack8(*(const u32x4*)(PROJ + (size_t)row * PSTR + C_S5G + col), g);
#pragma unroll
                    for (int e = 0; e < 8; ++e) o[e] = (DBG_ZERO & 1) ? 0.f : ((DBG_DBL & 1) ? 2.f : 1.f) * y[e] * sigmoidf_(z[e]) * siluf_(g[e]);
                    *(u32x4*)(MIX + (size_t)row * MIXW + col) = pack8(o); } }
    }
};

__device__ __forceinline__ void tconv(bf16_t* dst, int N, int K, const float* src1, int ld1, int n1, const float* src2, int ld2, int n2, int kvalid,
                      const float* sc, int ks0, LAS float* tile, int& rot, int bidx, int nb) {
    const int tid = ltid(); const int tn = N / 64, tk = K / 64, nt = tn * tk;
    for (int t = (bidx + rot) % nb; t < nt; t += nb) {
        const int n0 = (t % tn) * 64, k0 = (t / tn) * 64;
#pragma unroll
        for (int e = 0; e < 8; ++e) { const int idx = e * 512 + tid, kk = idx >> 6, nn = idx & 63, k = k0 + kk, n = n0 + nn;
            float v = 0.f;
            if (k < kvalid) { if (n < n1) v = src1[(size_t)k * ld1 + n]; else if (src2 && n < n2) v = src2[(size_t)k * ld2 + (n - n1)]; }
            if (sc && k >= ks0) v *= sc[k - ks0];
            tile[kk * 65 + nn] = v; }
        __syncthreads();
        { const int n = tid >> 3, ks = (tid & 7) * 8; float o[8];
#pragma unroll
          for (int j = 0; j < 8; ++j) o[j] = tile[(ks + j) * 65 + n];
          *(u32x4*)(dst + (size_t)(n0 + n) * K + k0 + ks) = pack8(o); }
        __syncthreads();
    }
    rot += nt;
}

__device__ __forceinline__ void prep_weights(const Ctx& p, int layer, LAS unsigned char* lds, int bidx, int nb) {
    unsigned char* ws = p.wsp(); const int tid = ltid(); const size_t lo = lofs(layer);
    LAS float* tile = (LAS float*)lds; int rot = 0;
    tconv((bf16_t*)(ws + OFF_WIN), NPAD, 1024, p.in(2) + (size_t)layer * 1024 * PW, PW, PW, layer ? p.in(3) : nullptr, 32, PW + 32, 1024, p.in(1) + layer * 1024, 0, tile, rot, bidx, nb);
    tconv((bf16_t*)(ws + OFF_WOUT + lo), 1024, 1536, p.in(33) + (size_t)layer * 1536 * 1024, 1024, 1024, nullptr, 0, 0, 1536, p.in(32) + layer * 512, 1024, tile, rot, bidx, nb);
    tconv((bf16_t*)(ws + OFF_WGLU + lo), 512, 512, p.in(12) + (size_t)layer * 512 * 512, 512, 512, nullptr, 0, 0, 512, nullptr, 0, tile, rot, bidx, nb);
    tconv((bf16_t*)(ws + OFF_WUP + lo), 512, 64, p.in(15) + (size_t)layer * 64 * 512, 512, 512, nullptr, 0, 0, 64, nullptr, 0, tile, rot, bidx, nb);
    tconv((bf16_t*)(ws + OFF_AUP + lo), 512, 64, p.in(17) + (size_t)layer * 64 * 512, 512, 512, nullptr, 0, 0, 64, nullptr, 0, tile, rot, bidx, nb);
    if (layer) tconv((bf16_t*)(ws + OFF_VUP + lo), 512, 64, p.in(25), 512, 512, nullptr, 0, 0, 32, nullptr, 0, tile, rot, bidx, nb);
    { const int gt = bidx * 512 + tid;
      if (gt < 2048) { const int g = gt >> 6, pp = gt & 63;
        const float dt = expf(p.in(4)[layer * 32 + g]); const float ar = p.in(5)[layer * 2048 + gt], ai = p.in(6)[layer * 2048 + gt];
        const float mag = expf(dt * ar); const float abr = mag * cosf(dt * ai), abi = mag * sinf(dt * ai);
        const float den = ar * ar + ai * ai; const float fre = ((abr - 1.0f) * ar + abi * ai) / den, fim = (abi * ar - (abr - 1.0f) * ai) / den;
        bf16_t* BB = (bf16_t*)(ws + OFF_BB + lo); bf16_t* CC = (bf16_t*)(ws + OFF_CC + lo);
        const float* br = p.in(7) + (size_t)layer * 32768 + (size_t)gt * 16; const float* bi = p.in(8) + (size_t)layer * 32768 + (size_t)gt * 16;
#pragma unroll 1
        for (int c = 0; c < 16; ++c) { BB[(g * 128 + pp) * 16 + c] = f2bf(fre * br[c] - fim * bi[c]); BB[(g * 128 + 64 + pp) * 16 + c] = f2bf(fre * bi[c] + fim * br[c]); }
        const float* cr = p.in(9) + (size_t)layer * 32768 + (size_t)g * 1024; const float* ci = p.in(10) + (size_t)layer * 32768 + (size_t)g * 1024;
#pragma unroll 1
        for (int c = 0; c < 32; ++c) { CC[(g * 32 + c) * 128 + pp] = c < 16 ? f2bf(cr[c * 64 + pp]) : (bf16_t)0; CC[(g * 32 + c) * 128 + 64 + pp] = c < 16 ? f2bf(-ci[c * 64 + pp]) : (bf16_t)0; }
        float2* AB = (float2*)(ws + OFF_ABAR + lo); float2* AB64 = (float2*)(ws + OFF_AB64 + lo);
        AB[gt] = make_float2(abr, abi);
        float xr = abr, xi = abi;
#pragma unroll 1
        for (int s = 0; s < 6; ++s) { const float nr = xr * xr - xi * xi, ni = 2.f * xr * xi; xr = nr; xi = ni; }
        AB64[gt] = make_float2(xr, xi); } }
}
__device__ __forceinline__ void prep_hb(const Ctx& p, int layer) {
    unsigned char* ws = p.wsp(); const int tid = ltid(), lane = tid & 63;
    { const float* x = p.in(0); const bf16_t* D0 = (const bf16_t*)(ws + OFF_D0); bf16_t* hb = (bf16_t*)(ws + OFF_R1);
      const int wv = blockIdx.x * 8 + (tid >> 6), nw = gridDim.x * 8;
      for (int t = wv; t < L_; t += 2 * nw) {
          f32x4 xa[4], xb[4]; u32x2 da[4], db[4];
#pragma unroll
          for (int j = 0; j < 4; ++j) { const size_t oa = (size_t)t * 1024 + j * 256 + lane * 4, ob = oa + (size_t)nw * 1024;
              xa[j] = *(const f32x4*)(x + oa); xb[j] = *(const f32x4*)(x + ob);
              if (layer) { da[j] = *(const u32x2*)(D0 + oa); db[j] = *(const u32x2*)(D0 + ob); } else { da[j] = (u32x2){0u, 0u}; db[j] = (u32x2){0u, 0u}; } }
          float sa = 0.f, sb = 0.f;
#pragma unroll
          for (int j = 0; j < 4; ++j) {
              xa[j][0] += __uint_as_float(da[j].x << 16); xa[j][1] += __uint_as_float(da[j].x & 0xffff0000u); xa[j][2] += __uint_as_float(da[j].y << 16); xa[j][3] += __uint_as_float(da[j].y & 0xffff0000u);
              xb[j][0] += __uint_as_float(db[j].x << 16); xb[j][1] += __uint_as_float(db[j].x & 0xffff0000u); xb[j][2] += __uint_as_float(db[j].y << 16); xb[j][3] += __uint_as_float(db[j].y & 0xffff0000u);
#pragma unroll
              for (int e = 0; e < 4; ++e) { sa += xa[j][e] * xa[j][e]; sb += xb[j][e] * xb[j][e]; } }
#pragma unroll
          for (int o = 32; o > 0; o >>= 1) { sa += shx(sa, o); sb += shx(sb, o); }
          const float ra = rsqrtf(sa * (1.0f / 1024.0f) + 1e-5f), rb = rsqrtf(sb * (1.0f / 1024.0f) + 1e-5f);
#pragma unroll
          for (int j = 0; j < 4; ++j) { const size_t oa = (size_t)t * 1024 + j * 256 + lane * 4, ob = oa + (size_t)nw * 1024; u32x2 w;
              w.x = pack2(xa[j][0] * ra, xa[j][1] * ra); w.y = pack2(xa[j][2] * ra, xa[j][3] * ra); *(u32x2*)(hb + oa) = w;
              w.x = pack2(xb[j][0] * rb, xb[j][1] * rb); w.y = pack2(xb[j][2] * rb, xb[j][3] * rb); *(u32x2*)(hb + ob) = w; } } }
}


#if DBG_PROBE
__device__ __forceinline__ void phase_probe(const Ctx& p) {
    unsigned char* ws = p.wsp(); bf16_t* R = (bf16_t*)(ws + OFF_R1);
    const bf16_t* PROJ = (const bf16_t*)(ws + OFF_PROJ); const bf16_t* MIX = (const bf16_t*)(p.outp() + OUT_MIX);
    const bf16_t* YB = (const bf16_t*)(p.outp() + OUT_SEN); const bf16_t* D0 = (const bf16_t*)(ws + OFF_D0);
    const float* SSQ = (const float*)(ws + OFF_SSQ);
    const size_t n = (size_t)L_ * 1024;
    for (size_t i = (size_t)blockIdx.x * 512 + ltid(); i < n; i += (size_t)gridDim.x * 512) {
        const int t = (int)(i >> 10), c = (int)(i & 1023); float v = 0.f;
        if (DBG_PROBE == 1) { for (int k = 0; k < 4; ++k) v += bf2f(PROJ[(size_t)t * PSTR + c + 1024 * k]); if (c < 704) v += bf2f(PROJ[(size_t)t * PSTR + 4096 + c]); }
        if (DBG_PROBE == 2) v = bf2f(MIX[(size_t)t * MIXW + (c & 511)]);
        if (DBG_PROBE == 3) v = bf2f(MIX[(size_t)t * MIXW + 512 + (c & 511)]);
        if (DBG_PROBE == 4) v = bf2f(MIX[(size_t)t * MIXW + 1024 + (c & 511)]);
        if (DBG_PROBE == 5) v = bf2f(D0[i]);
        if (DBG_PROBE == 6) v = bf2f(YB[(size_t)t * 512 + (c & 511)]);
        if (DBG_PROBE == 7) v = SSQ[t * 8 + (c & 7)];
        if (DBG_PROBE == 8) v = bf2f(((const bf16_t*)(ws + OFF_WIN))[i]) + bf2f(((const bf16_t*)(ws + OFF_WOUT))[i & (1024 * 1536 - 1)]);
        if (DBG_PROBE == 9) v = ((const float*)(ws + OFF_S5E))[i & (1048576 - 1)];
        if (DBG_PROBE == 10) v = bf2f(((const bf16_t*)(ws + OFF_BB))[i & 65535]) + bf2f(((const bf16_t*)(ws + OFF_CC))[i & 131071]) + ((const float*)(ws + OFF_ABAR))[i & 4095] + ((const float*)(ws + OFF_AB64))[i & 4095];
        R[i] = f2bf(v);
    }
}
#endif
__device__ __forceinline__ void phase_final(const Ctx& p) {
    const bf16_t* h2 = (const bf16_t*)(p.wsp() + OFF_PROJ);     const float* g = p.in(34); float* out = p.out; const float* x = p.in(0); const bf16_t* D0 = (const bf16_t*)(p.wsp() + OFF_D0);
    const int tid = ltid(), lane = tid & 63; const int wv = blockIdx.x * 8 + (tid >> 6), nw = gridDim.x * 8;
#if DBG_PROF
    const unsigned long long* pa_ = (const unsigned long long*)(p.wsp() + OFF_PROF); const unsigned long long tot_ = wall_clock64() - pa_[1];
    const int zrows = 512 * (int)((double)pa_[0] / (double)tot_ * 32.0 + 0.5);
#endif
    for (int t = wv; t < L_; t += 2 * nw) {
        f32x4 va[4], vb[4]; u32x2 da[4], db[4], ha[4], hb2[4];
#pragma unroll
        for (int j = 0; j < 4; ++j) { const size_t oa = (size_t)t * 1024 + j * 256 + lane * 4, ob = oa + (size_t)nw * 1024;
            va[j] = *(const f32x4*)(x + oa); vb[j] = *(const f32x4*)(x + ob);
            da[j] = *(const u32x2*)(D0 + oa); db[j] = *(const u32x2*)(D0 + ob);
            ha[j] = *(const u32x2*)(h2 + oa); hb2[j] = *(const u32x2*)(h2 + ob); }
        float sa = 0.f, sb = 0.f;
#pragma unroll
        for (int j = 0; j < 4; ++j) {
            va[j][0] += __uint_as_float(da[j].x << 16) + __uint_as_float(ha[j].x << 16); va[j][1] += __uint_as_float(da[j].x & 0xffff0000u) + __uint_as_float(ha[j].x & 0xffff0000u);
            va[j][2] += __uint_as_float(da[j].y << 16) + __uint_as_float(ha[j].y << 16); va[j][3] += __uint_as_float(da[j].y & 0xffff0000u) + __uint_as_float(ha[j].y & 0xffff0000u);
            vb[j][0] += __uint_as_float(db[j].x << 16) + __uint_as_float(hb2[j].x << 16); vb[j][1] += __uint_as_float(db[j].x & 0xffff0000u) + __uint_as_float(hb2[j].x & 0xffff0000u);
            vb[j][2] += __uint_as_float(db[j].y << 16) + __uint_as_float(hb2[j].y << 16); vb[j][3] += __uint_as_float(db[j].y & 0xffff0000u) + __uint_as_float(hb2[j].y & 0xffff0000u);
#pragma unroll
            for (int e = 0; e < 4; ++e) { sa += va[j][e] * va[j][e]; sb += vb[j][e] * vb[j][e]; } }
#pragma unroll
        for (int o = 32; o > 0; o >>= 1) { sa += shx(sa, o); sb += shx(sb, o); }
        const float ra = rsqrtf(sa * (1.0f / 1024.0f) + 1e-5f), rb = rsqrtf(sb * (1.0f / 1024.0f) + 1e-5f);
#pragma unroll
        for (int j = 0; j < 4; ++j) { const size_t oa = (size_t)t * 1024 + j * 256 + lane * 4, ob = oa + (size_t)nw * 1024; const f32x4 gv = *(const f32x4*)(g + j * 256 + lane * 4);
            *(f32x4*)(out + oa) = va[j] * ra * gv; *(f32x4*)(out + ob) = vb[j] * rb * gv; }
    }
}

__device__ __forceinline__ void m2_normalize(const Ctx& p, int b0, int nb) {
    bf16_t* mix = (bf16_t*)(p.outp() + OUT_MIX); const float* ssq = (const float*)(p.wsp() + OFF_SSQ);
    const int tid = ltid(), lane = tid & 63; const int wv = (blockIdx.x - b0) * 8 + (tid >> 6), nw = nb * 8;
    for (int t = wv; t < L_; t += nw) {
        float s = 0.f;
#pragma unroll
        for (int h = 0; h < 8; ++h) s += ssq[t * 8 + h];
        const float rs = ((DBG_DBL & 4) ? 2.f : 1.f) * rsqrtf(s * (1.0f / 512.0f) + 1e-5f);
        bf16_t* ptr = mix + (size_t)t * MIXW + 1024 + lane * 8; float o[8]; unpack8(*(const u32x4*)ptr, o);
#pragma unroll
        for (int e = 0; e < 8; ++e) o[e] *= rs;
        *(u32x4*)ptr = pack8(o);
    }
}

constexpr int TS = 72;
constexpr int FS = 68;
template <int PASS>
__device__ __forceinline__ void rwkv_pass(const Ctx& p, int layer, LAS unsigned char* tl, int team_gid, int nteams) {
    unsigned char* ws = p.wsp();
    const int tt0 = ltid() & 255;
    const bf16_t* PROJ = (const bf16_t*)(ws + OFF_PROJ);
    bf16_t* MtG = (bf16_t*)(ws + OFF_R1); bf16_t* NG = MtG + (size_t)2048 * 4096;
    bf16_t* SEN = (bf16_t*)(p.outp() + OUT_SEN);
    bf16_t* MIX = (bf16_t*)(p.outp() + OUT_MIX);
    bf16_t* VF = (bf16_t*)(ws + OFF_VF);
    const bf16_t* WUP = (const bf16_t*)(ws + OFF_WUP + lofs(layer)); const bf16_t* AUP = (const bf16_t*)(ws + OFF_AUP + lofs(layer)); const bf16_t* VUP = (const bf16_t*)(ws + OFF_VUP + lofs(layer));
    const float* mu = p.in(14) + layer * 2176;
    LAS float* PT = (LAS float*)(tl + 73728);
    LAS bf16_t* TW = (LAS bf16_t*)(tl + 0); LAS bf16_t* TA = (LAS bf16_t*)(tl + 9216); LAS bf16_t* TV = (LAS bf16_t*)(tl + 18432);
    LAS float* LW = (LAS float*)(tl + 27648); LAS bf16_t* AS = (LAS bf16_t*)(tl + 45056); LAS bf16_t* SV = (LAS bf16_t*)(tl + 54272);
    LAS bf16_t* At = (LAS bf16_t*)(tl + (PASS == 1 ? 0 : 36864));
    LAS bf16_t* VT = (LAS bf16_t*)(tl + 9216);
    LAS bf16_t* BT = (LAS bf16_t*)(tl + 18432);
    LAS bf16_t* KT = (LAS bf16_t*)(tl + 27648);
    LAS bf16_t* Rn = (LAS bf16_t*)(tl + 0);
    LAS bf16_t* Bn = (LAS bf16_t*)(tl + (PASS == 1 ? 36864 : 18432));
    LAS bf16_t* Kn = (LAS bf16_t*)(tl + (PASS == 1 ? 46080 : 27648));
    LAS float* AAB = (LAS float*)(tl + (PASS == 1 ? 36864 : 18432));
    LAS bf16_t* AK = (LAS bf16_t*)(tl + (PASS == 1 ? 55296 : 46080));
    LAS float* XF = (LAS float*)(tl + (PASS == 1 ? 55296 : 36864));
    LAS bf16_t* UT0 = (LAS bf16_t*)(tl + (PASS == 1 ? 55296 : 36864));
    LAS bf16_t* UT1 = (LAS bf16_t*)(tl + 64512);
    LAS bf16_t* ARB = (LAS bf16_t*)(tl + 55296); LAS bf16_t* ARK = (LAS bf16_t*)(tl + 64512);

    for (int item = team_gid; item < 2048; item += nteams) {
        const int c = item >> 3, h = item & 7, t0 = c * 64;
        int tt = tt0; asm volatile("" : "+v"(tt));
        const int wq = __builtin_amdgcn_readfirstlane(tt >> 6), lane = tt & 63, ti = wq >> 1, tj = wq & 1;
        const int t = tt >> 2, seg = tt & 3, gt = t0 + t;
        const bf16_t* crow = PROJ + (size_t)gt * PSTR; const bf16_t* prow = gt > 0 ? crow - PSTR : nullptr;
        float inv; u32x4 kpk0, kpk1;
        { float kk[16]; const int co = 64 * h + seg * 16; const float* kkp = p.in(19) + layer * 512 + co; float ssq = 0.f;
          ld16_lerp(crow + C_K + co, prow ? prow + C_K + co : nullptr, mu + (C_K - C_RW) + co, kk);
#pragma unroll
          for (int e = 0; e < 16; ++e) { const float x = kk[e] * kkp[e]; ssq += x * x; }
          ssq += shx(ssq, 1); ssq += shx(ssq, 2);
          inv = 1.0f / fmaxf(sqrtf(ssq), 1e-12f); kpk0 = pack8(kk); kpk1 = pack8(kk + 8); }
        PROF_T0(3);
        { float o[16];
          ld16_lerp(crow + C_WD + seg * 16, prow ? prow + C_WD + seg * 16 : nullptr, mu + (C_WD - C_RW) + seg * 16, o);
#pragma unroll
          for (int e = 0; e < 16; ++e) o[e] = tanh_fast_(o[e]);
          st16_lds(TW + t * TS + seg * 16, o);
          ld16_lerp(crow + C_AD + seg * 16, prow ? prow + C_AD + seg * 16 : nullptr, mu + (C_AD - C_RW) + seg * 16, o);
          st16_lds(TA + t * TS + seg * 16, o);
          if (layer) { if (seg < 2) ld16_lerp(crow + C_VD + seg * 16, prow ? prow + C_VD + seg * 16 : nullptr, p.in(24) + seg * 16, o); else {
#pragma unroll
                  for (int e = 0; e < 16; ++e) o[e] = 0.f; }
              st16_lds(TV + t * TS + seg * 16, o); } }
        __syncthreads();
        { f32x16 aw = mma_lg(zero16(), TW + ti * 32 * TS, TS, WUP + (size_t)(64 * h + tj * 32) * 64, 64, 64, lane);
          f32x16 aa = mma_lg(zero16(), TA + ti * 32 * TS, TS, AUP + (size_t)(64 * h + tj * 32) * 64, 64, 64, lane);
          f32x16 av = zero16(); if (layer) av = mma_lg(av, TV + ti * 32 * TS, TS, VUP + (size_t)(64 * h + tj * 32) * 64, 64, 64, lane);
          const int cc = tj * 32 + (lane & 31), ch = 64 * h + cc;
          const float w0 = p.in(16)[layer * 512 + ch], a0 = p.in(18)[layer * 512 + ch], v0 = layer ? p.in(26)[ch] : 0.f;
#pragma unroll
          for (int j = 0; j < 16; ++j) { const int r = ti * 32 + ACC_ROW(j, lane);
              const float xw = w0 + aw[j];
              LW[r * FS + cc] = -0.60653065971f * sigmoidf_(xw);
              AS[r * TS + cc] = f2bf(sigmoidf_(a0 + aa[j]));
              if (layer) SV[r * TS + cc] = f2bf(sigmoidf_(v0 + av[j])); } }
        __syncthreads();
        { LAS float* TOT = (LAS float*)(tl + 73728 + 256);
          const int rb = wq * 16; float lv[16];
#pragma unroll
          for (int j = 0; j < 16; ++j) lv[j] = LW[(rb + j) * FS + lane];
#pragma unroll
          for (int j = 1; j < 16; ++j) lv[j] += lv[j - 1];
          TOT[wq * 64 + lane] = lv[15];
          __syncthreads();
          float off = 0.f;
#pragma unroll
          for (int b = 0; b < 3; ++b) if (b < wq) off += TOT[b * 64 + lane];
#pragma unroll
          for (int j = 0; j < 16; ++j) LW[(rb + j) * FS + lane] = __expf(lv[j] + off); }
        __syncthreads();
        PROF_T1(3, ws);
        PROF_T0(2);
        float vv[16]; float bonus = 0.f;
        float hA0[8], hB0[8], hA1[8], hB1[8];
#define S4_HALF(HF, HA, HB) do { \
          const int c8 = seg * 16 + (HF) * 8, co8 = 64 * h + c8; \
          float cum[8], cumm[8], av_[8], sv_[8], rr[8], kq[8], v8[8]; \
          _Pragma("unroll") for (int e = 0; e < 8; ++e) { cum[e] = LW[t * FS + c8 + e]; cumm[e] = t > 0 ? LW[(t - 1) * FS + c8 + e] : 1.f; av_[e] = bf2f(AS[t * TS + c8 + e]); sv_[e] = layer ? bf2f(SV[t * TS + c8 + e]) : 0.f; } \
          if (t == 63) { _Pragma("unroll") for (int e = 0; e < 8; ++e) PT[c8 + e] = cum[e]; } \
          ld8_lerp(crow + C_R + co8, prow ? prow + C_R + co8 : nullptr, mu + (C_R - C_RW) + co8, rr); \
          unpack8((HF) ? kpk1 : kpk0, kq); \
          ld8_lerp(crow + C_V + co8, prow ? prow + C_V + co8 : nullptr, mu + (C_V - C_RW) + co8, v8); \
          if (layer) { float vf[8]; unpack8(*(const u32x4*)(VF + (size_t)gt * 512 + co8), vf); \
              _Pragma("unroll") for (int e = 0; e < 8; ++e) v8[e] = v8[e] + (vf[e] - v8[e]) * sv_[e]; } \
          else if (PASS == 3) *(u32x4*)(VF + (size_t)gt * 512 + co8) = pack8(v8); \
          const float* kkp8 = p.in(19) + layer * 512 + co8; const float* kap8 = p.in(20) + layer * 512 + co8; const float* rkp8 = p.in(21) + layer * 512 + co8; \
          float oa[8], orr[8]; \
          _Pragma("unroll") for (int e = 0; e < 8; ++e) { const float kkn = kq[e] * kkp8[e] * inv; const float a = av_[e]; const float k2 = kq[e] * (1.0f + (a - 1.0f) * kap8[e]); \
              const float Pt = cum[e], Pm = cumm[e], iP = __builtin_amdgcn_rcpf(Pt); \
              oa[e] = -kkn * Pm; const float obv = kkn * a * iP; const float okv = k2 * iP; orr[e] = rr[e] * Pt; bonus += rr[e] * k2 * rkp8[e]; \
              vv[(HF) * 8 + e] = v8[e]; VT[(c8 + e) * TS + t] = f2bf(v8[e]); \
              if (PASS == 1) { BT[(c8 + e) * TS + t] = f2bf(obv); HA[e] = obv; HB[e] = okv; } else { HA[e] = oa[e]; HB[e] = okv; oa[e] = obv; } } \
          if (PASS == 1) *(LAS u32x4*)(At + t * TS + c8) = pack8(oa); \
          else { *(LAS u32x4*)(Rn + t * TS + c8) = pack8(orr); *(LAS u32x4*)(Bn + t * TS + c8) = pack8(oa); } \
        } while (0)
        S4_HALF(0, hA0, hB0);
        if (PASS == 3) __builtin_amdgcn_sched_barrier(0);
        S4_HALF(1, hA1, hB1);
#undef S4_HALF
        bonus += shx(bonus, 1); bonus += shx(bonus, 2);
        __syncthreads();
        { const int c0 = seg * 16;
          if (PASS == 1) { *(LAS u32x4*)(Bn + t * TS + c0) = pack8(hA0); *(LAS u32x4*)(Bn + t * TS + c0 + 8) = pack8(hA1);
              *(LAS u32x4*)(Kn + t * TS + c0) = pack8(hB0); *(LAS u32x4*)(Kn + t * TS + c0 + 8) = pack8(hB1);
#pragma unroll
              for (int e = 0; e < 8; ++e) { KT[(c0 + e) * TS + t] = f2bf(hB0[e]); KT[(c0 + 8 + e) * TS + t] = f2bf(hB1[e]); } }
          else { *(LAS u32x4*)(At + t * TS + c0) = pack8(hA0); *(LAS u32x4*)(At + t * TS + c0 + 8) = pack8(hA1);
              *(LAS u32x4*)(Kn + t * TS + c0) = pack8(hB0); *(LAS u32x4*)(Kn + t * TS + c0 + 8) = pack8(hB1); } }
        __syncthreads();
        PROF_T1(2, ws);
        PROF_T0(4);
        { const int s = tj * 32 + (lane & 31);
          { f32x16 ak = mma_ll(zero16(), At + ti * 32 * TS, TS, Kn + tj * 32 * TS, TS, 64, lane);
#pragma unroll
            for (int j = 0; j < 16; ++j) { const int r = ti * 32 + ACC_ROW(j, lane); AK[r * TS + s] = (s < r) ? f2bf(ak[j]) : (bf16_t)0; } }
          if (PASS == 3) {
              { f32x16 rb = mma_ll(zero16(), Rn + ti * 32 * TS, TS, Bn + tj * 32 * TS, TS, 64, lane);
#pragma unroll
                for (int j = 0; j < 16; ++j) { const int r = ti * 32 + ACC_ROW(j, lane); ARB[r * TS + s] = (s <= r) ? f2bf(rb[j]) : (bf16_t)0; } }
              { f32x16 rk = mma_ll(zero16(), Rn + ti * 32 * TS, TS, Kn + tj * 32 * TS, TS, 64, lane);
#pragma unroll
                for (int j = 0; j < 16; ++j) { const int r = ti * 32 + ACC_ROW(j, lane); ARK[r * TS + s] = (s <= r) ? f2bf(rk[j]) : (bf16_t)0; } } }
          f32x16 ab = mma_ll(zero16(), At + ti * 32 * TS, TS, Bn + tj * 32 * TS, TS, 64, lane);
          __syncthreads();
#pragma unroll
          for (int q = 0; q < 4; ++q) { const int r0 = ti * 32 + 8 * q + 4 * (lane >> 5);
              *(LAS f32x4*)(AAB + s * FS + r0) = (f32x4){ab[4 * q], ab[4 * q + 1], ab[4 * q + 2], ab[4 * q + 3]}; } }
        __syncthreads();
        const bf16_t* S0 = SEN + (size_t)item * 4096;
        { f32x16 x = mma_ll(zero16(), AK + ti * 32 * TS, TS, VT + tj * 32 * TS, TS, 64, lane);
          if (PASS == 3) x = mma_lg(x, At + ti * 32 * TS, TS, S0 + (size_t)(tj * 32) * 64, 64, 64, lane);
          __syncthreads();
          const int v = tj * 32 + (lane & 31);
#pragma unroll
          for (int j = 0; j < 16; ++j) { const int r = ti * 32 + ACC_ROW(j, lane); XF[r * FS + v] = x[j]; } }
        __syncthreads();
        PROF_T1(4, ws);
        PROF_T0(1);
        { const int aw0 = (PASS == 1) ? 2 * (team_gid & 1) : (team_gid & 1);
          const bool active = (PASS == 1) ? (wq == aw0 || wq == aw0 + 1) : (wq == aw0);
          if (active) {
              const bool BF = (PASS == 1 && wq == aw0);
#pragma unroll 1
              for (int b16 = 0; b16 < 64; b16 += 16) {
                  float acc[16];
#pragma unroll
                  for (int i = 0; i < 16; ++i) acc[i] = BF ? bf2f(At[(b16 + i) * TS + lane]) : XF[(b16 + i) * FS + lane];
#pragma unroll 4
                  for (int s = 0; s < b16; ++s) { const float us = BF ? bf2f(At[s * TS + lane]) : XF[s * FS + lane];
                      const LAS f32x4* cp = (const LAS f32x4*)(AAB + s * FS + b16);
                      const f32x4 c0 = cp[0], c1 = cp[1], c2 = cp[2], c3 = cp[3];
#pragma unroll
                      for (int e = 0; e < 4; ++e) { acc[e] += c0[e] * us; acc[4 + e] += c1[e] * us; acc[8 + e] += c2[e] * us; acc[12 + e] += c3[e] * us; } }
#pragma unroll
                  for (int j = 0; j < 15; ++j) { float uj = acc[j];
                      if (BF) uj = bf2f(f2bf(uj));
                      const LAS float* cp = AAB + (b16 + j) * FS + b16;
#pragma unroll
                      for (int i = j + 1; i < 16; ++i) acc[i] += cp[i] * uj;
                      __builtin_amdgcn_sched_barrier(0); }
#pragma unroll
                  for (int i = 0; i < 16; ++i) { if (BF) At[(b16 + i) * TS + lane] = f2bf(acc[i]); else XF[(b16 + i) * FS + lane] = acc[i]; }
              } }
          __syncthreads();
          float ux[16]; u32x4 w0, w1;
#pragma unroll
          for (int e = 0; e < 16; ++e) ux[e] = XF[t * FS + seg * 16 + e];
          if (PASS == 1) { w0 = *(const LAS u32x4*)(At + t * TS + seg * 16); w1 = *(const LAS u32x4*)(At + t * TS + seg * 16 + 8); }
          __syncthreads();
          if (PASS == 1) { float wx[16]; unpack8(w0, wx); unpack8(w1, wx + 8);
#pragma unroll
              for (int e = 0; e < 16; ++e) { UT0[(seg * 16 + e) * TS + t] = f2bf(wx[e]); UT1[(seg * 16 + e) * TS + t] = f2bf(ux[e]); } }
          else {
#pragma unroll
              for (int e = 0; e < 16; ++e) UT0[(seg * 16 + e) * TS + t] = f2bf(ux[e]); } }
        __syncthreads();
        PROF_T1(1, ws);
        PROF_T0(5);
        if (PASS == 1) {
            f32x16 m = mma_ll(zero16(), UT0 + ti * 32 * TS, TS, BT + tj * 32 * TS, TS, 64, lane);
            f32x16 n = mma_ll(zero16(), BT + ti * 32 * TS, TS, UT1 + tj * 32 * TS, TS, 64, lane);
            n = mma_ll(n, KT + ti * 32 * TS, TS, VT + tj * 32 * TS, TS, 64, lane);
            const int col = tj * 32 + (lane & 31); const float ptc = PT[col];
            bf16_t* mg = MtG + (size_t)item * 4096; bf16_t* ng = NG + (size_t)item * 4096;
#pragma unroll
            for (int q = 0; q < 4; ++q) { const int r0 = ti * 32 + 8 * q + 4 * (lane >> 5); float mv[4], nv[4];
#pragma unroll
                for (int e = 0; e < 4; ++e) { mv[e] = (m[4 * q + e] + ((r0 + e) == col ? 1.0f : 0.0f)) * ptc; nv[e] = n[4 * q + e] * PT[r0 + e]; }
                { u32x2 w; w.x = pack2(mv[0], mv[1]); w.y = pack2(mv[2], mv[3]);
                  const int mo = col >> 4, li = col & 15, ks = r0 >> 5, rem = r0 & 31, hi = rem >> 4, g = (rem & 15) >> 2;
                  *(u32x2*)(mg + (((mo * 2 + ks) * 64 + g * 16 + li) * 8 + 4 * hi)) = w; }
                { u32x2 w; w.x = pack2(nv[0], nv[1]); w.y = pack2(nv[2], nv[3]);
                  const int slv = col >> 4, li = col & 15, mo = r0 >> 4, g = (r0 & 15) >> 2;
                  *(u32x2*)(ng + (((slv * 4 + mo) * 64 + g * 16 + li) * 4)) = w; } }
        } else {
            f32x16 y = mma_lg(zero16(), Rn + ti * 32 * TS, TS, S0 + (size_t)(tj * 32) * 64, 64, 64, lane);
            y = mma_ll(y, ARB + ti * 32 * TS, TS, UT0 + tj * 32 * TS, TS, 64, lane);
            y = mma_ll(y, ARK + ti * 32 * TS, TS, VT + tj * 32 * TS, TS, 64, lane);
            __syncthreads();
            const int v = tj * 32 + (lane & 31);
#pragma unroll
            for (int j = 0; j < 16; ++j) { const int r = ti * 32 + ACC_ROW(j, lane); XF[r * FS + v] = y[j]; }
            __syncthreads();
            float yv[16]; float sm = 0.f;
#pragma unroll
            for (int e = 0; e < 16; ++e) { yv[e] = XF[t * FS + seg * 16 + e]; sm += yv[e]; }
            sm += shx(sm, 1); sm += shx(sm, 2);
            const float mean = sm * (1.0f / 64.0f); float vs = 0.f;
#pragma unroll
            for (int e = 0; e < 16; ++e) { const float d = yv[e] - mean; vs += d * d; }
            vs += shx(vs, 1); vs += shx(vs, 2);
            const float rs = rsqrtf(vs * (1.0f / 64.0f) + 64e-5f);
            const int co = 64 * h + seg * 16; const float* lg = p.in(22) + layer * 512 + co; const float* lb = p.in(23) + layer * 512 + co;
            float o[16], gg[16];
            ld16_lerp(crow + C_G + co, prow ? prow + C_G + co : nullptr, mu + (C_G - C_RW) + co, gg);
#pragma unroll
            for (int e = 0; e < 16; ++e) { const float yn = (yv[e] - mean) * rs * lg[e] + lb[e] + bonus * vv[e]; o[e] = ((DBG_DBL & 2) ? 2.f : 1.f) * yn * siluf_(gg[e]); }
#if DBG_NORW
#pragma unroll
            for (int e = 0; e < 16; ++e) o[e] = 0.f;
#endif
            st16_g(MIX + (size_t)gt * MIXW + 512 + co, o);
        }
        __syncthreads();
        PROF_T1(5, ws);
    }
}


#if DBG_SLOWR
__device__ __forceinline__ float xs_lerp(const bf16_t* crow, const bf16_t* prow, int col, float mu) {
    const float c = bf2f(crow[col]); const float q = prow ? bf2f(prow[col]) : 0.f; return c + (q - c) * mu; }
__device__ __forceinline__ void rwkv_slow(const Ctx& p, int layer, LAS unsigned char* lds) {
    if (blockIdx.x >= 8 || ltid() >= 64) return;
    unsigned char* ws = p.wsp(); const bf16_t* PROJ = (const bf16_t*)(ws + OFF_PROJ); bf16_t* MIX = (bf16_t*)(p.outp() + OUT_MIX); bf16_t* VF = (bf16_t*)(ws + OFF_VF);
    const int h = blockIdx.x, c = ltid() & 63, ch = 64 * h + c;
    const float* mu = p.in(14) + layer * 2176; const float* wup = p.in(15) + (size_t)layer * 64 * 512; const float* aup = p.in(17) + (size_t)layer * 64 * 512; const float* vup = p.in(25);
    const float w0 = p.in(16)[layer * 512 + ch], a0 = p.in(18)[layer * 512 + ch], kkw = p.in(19)[layer * 512 + ch], kaw = p.in(20)[layer * 512 + ch], rkw = p.in(21)[layer * 512 + ch];
    const float lng = p.in(22)[layer * 512 + ch], lnb = p.in(23)[layer * 512 + ch]; const float v0 = layer ? p.in(26)[ch] : 0.f;
    const float mu_wd = mu[1536 + c], mu_ad = mu[1600 + c], mu_r = mu[ch], mu_k = mu[512 + ch], mu_v = mu[1024 + ch], mu_g = mu[1664 + ch]; const float mu_vd = (layer && c < 32) ? p.in(24)[c] : 0.f;
    LAS float* T1 = (LAS float*)lds;
    LAS float* VEC = (LAS float*)(lds + 1024);
    LAS float* SL = (LAS float*)(lds + 4096);
#pragma unroll 1
    for (int k = 0; k < 64; ++k) SL[k * 64 + c] = 0.f;
#pragma unroll 1
    for (int t = 0; t < L_; ++t) {
        const bf16_t* crow = PROJ + (size_t)t * PSTR; const bf16_t* prow = t > 0 ? crow - PSTR : nullptr;
        T1[c] = tanhf(xs_lerp(crow, prow, C_WD + c, mu_wd)); T1[64 + c] = xs_lerp(crow, prow, C_AD + c, mu_ad); T1[128 + c] = (layer && c < 32) ? xs_lerp(crow, prow, C_VD + c, mu_vd) : 0.f;
        asm volatile("s_waitcnt lgkmcnt(0)" ::: "memory");
        float wl = 0.f, al = 0.f, vl = 0.f;
#pragma unroll 2
        for (int j = 0; j < 64; ++j) { const float* wr = wup + j * 512; const float* ar = aup + j * 512; wl += T1[j] * wr[ch]; al += T1[64 + j] * ar[ch]; }
        if (layer) {
#pragma unroll 2
            for (int j = 0; j < 32; ++j) { const float* vr = vup + j * 512; vl += T1[128 + j] * vr[ch]; } }
        const float wlog = -softplusf_(-(w0 + wl)) - 0.5f; const float dec = __expf(-__expf(wlog)); const float a = sigmoidf_(a0 + al);
        const float r = xs_lerp(crow, prow, C_R + ch, mu_r), k = xs_lerp(crow, prow, C_K + ch, mu_k), g = xs_lerp(crow, prow, C_G + ch, mu_g); float v = xs_lerp(crow, prow, C_V + ch, mu_v);
        if (layer) { const float vf = bf2f(VF[(size_t)t * 512 + ch]); v = v + (vf - v) * sigmoidf_(v0 + vl); } else VF[(size_t)t * 512 + ch] = f2bf(v);
        float kk = k * kkw; float ss = kk * kk;
#pragma unroll
        for (int o = 32; o > 0; o >>= 1) ss += shx(ss, o);
        kk = kk / fmaxf(sqrtf(ss), 1e-12f);
        const float k2 = k * (1.0f + (a - 1.0f) * kaw);
        __builtin_amdgcn_wave_barrier();
        VEC[c] = r; VEC[64 + c] = dec; VEC[128 + c] = k2; VEC[192 + c] = -kk; VEC[256 + c] = kk * a;
        asm volatile("s_waitcnt lgkmcnt(0)" ::: "memory");
        float sa = 0.f;
#pragma unroll 4
        for (int k = 0; k < 64; ++k) sa += SL[k * 64 + c] * VEC[192 + k];
        float y = 0.f;
#pragma unroll 4
        for (int k = 0; k < 64; ++k) { const float s = SL[k * 64 + c] * VEC[64 + k] + sa * VEC[256 + k] + v * VEC[128 + k]; SL[k * 64 + c] = s; y += s * VEC[k]; }
        float sm = y, bo = r * k2 * rkw;
#pragma unroll
        for (int o = 32; o > 0; o >>= 1) { sm += shx(sm, o); bo += shx(bo, o); }
        const float mean = sm * (1.0f / 64.0f); float vs = (y - mean) * (y - mean);
#pragma unroll
        for (int o = 32; o > 0; o >>= 1) vs += shx(vs, o);
        const float yn = (y - mean) * rsqrtf(vs * (1.0f / 64.0f) + 64e-5f) * lng + lnb + bo * v;
        MIX[(size_t)t * MIXW + 512 + ch] = f2bf(yn * siluf_(g));
        __builtin_amdgcn_wave_barrier();
    }
}
#endif

__device__ __forceinline__ void rwkv_scan(const Ctx& p, int wid, LAS unsigned char* wl) {
    const int lane = ltid() & 63; const int h = wid >> 2, sl = wid & 3, v0 = sl * 16, g = lane >> 4, li = lane & 15;
    const bf16_t* MtG = (const bf16_t*)(p.wsp() + OFF_R1); const bf16_t* NG = MtG + (size_t)2048 * 4096;
    bf16_t* SEN = (bf16_t*)(p.outp() + OUT_SEN);
    f32x4 acc[4];
#pragma unroll
    for (int n = 0; n < 4; ++n) acc[n] = (f32x4){0.f, 0.f, 0.f, 0.f};
    u32x4 aA[8], aB[8], aC[8], aD[8]; u32x2 nA[4], nB[4], nC[4], nD[4];
#define SCAN_LOAD(A_, N_, cc) do { const int c_ = (cc) < 256 ? (cc) : 255; const size_t ib_ = (size_t)(c_ * 8 + h) * 4096; \
        _Pragma("unroll") for (int mo = 0; mo < 4; ++mo) { \
            N_[mo] = *(const u32x2*)(NG + ib_ + ((sl * 4 + mo) * 64 + lane) * 4); \
            A_[2 * mo] = *(const u32x4*)(MtG + ib_ + ((mo * 2) * 64 + lane) * 8); \
            A_[2 * mo + 1] = *(const u32x4*)(MtG + ib_ + ((mo * 2 + 1) * 64 + lane) * 8); } } while (0)
#define SCAN_STEP(A_, N_, cc) do { const size_t ib_ = (size_t)((cc) * 8 + h) * 4096; \
        u32x2 pk[4]; \
        _Pragma("unroll") for (int mt = 0; mt < 4; ++mt) { pk[mt].x = pack2(acc[mt][0], acc[mt][1]); pk[mt].y = pack2(acc[mt][2], acc[mt][3]); \
            *(u32x2*)(SEN + ib_ + (v0 + li) * 64 + 16 * mt + 4 * g) = pk[mt]; } \
        const bf16x8 b0 = __builtin_bit_cast(bf16x8, ((u32x4){pk[0].x, pk[0].y, pk[1].x, pk[1].y})); \
        const bf16x8 b1 = __builtin_bit_cast(bf16x8, ((u32x4){pk[2].x, pk[2].y, pk[3].x, pk[3].y})); \
        _Pragma("unroll") for (int mo = 0; mo < 4; ++mo) { f32x4 na; \
            na[0] = __uint_as_float(N_[mo].x << 16); na[1] = __uint_as_float(N_[mo].x & 0xffff0000u); na[2] = __uint_as_float(N_[mo].y << 16); na[3] = __uint_as_float(N_[mo].y & 0xffff0000u); \
            na = __builtin_amdgcn_mfma_f32_16x16x32_bf16(__builtin_bit_cast(bf16x8, A_[2 * mo]), b0, na, 0, 0, 0); \
            acc[mo] = __builtin_amdgcn_mfma_f32_16x16x32_bf16(__builtin_bit_cast(bf16x8, A_[2 * mo + 1]), b1, na, 0, 0, 0); } } while (0)
    SCAN_LOAD(aA, nA, 0); SCAN_LOAD(aB, nB, 1); SCAN_LOAD(aC, nC, 2);
#pragma unroll 1
    for (int c = 0; c < 256; c += 4) {
        SCAN_LOAD(aD, nD, c + 3); SCAN_STEP(aA, nA, c);
        SCAN_LOAD(aA, nA, c + 4); SCAN_STEP(aB, nB, c + 1);
        SCAN_LOAD(aB, nB, c + 5); SCAN_STEP(aC, nC, c + 2);
        SCAN_LOAD(aC, nC, c + 6); SCAN_STEP(aD, nD, c + 3);
    }
#undef SCAN_LOAD
#undef SCAN_STEP
}

constexpr int BS_ = 136;
__device__ __forceinline__ void conv16(const bf16_t* PROJ, int gt, int ch0, const float* cw  , const float* cb, float* o) {
#pragma unroll
    for (int e = 0; e < 16; ++e) o[e] = cb[ch0 + e];
#pragma unroll
    for (int j = 0; j < 4; ++j) { const int ts = gt - 3 + j;
        if (ts >= 0) { float x[16]; ld16(PROJ + (size_t)ts * PSTR + C_X + ch0, x);
#pragma unroll
            for (int e = 0; e < 16; ++e) o[e] += cw[j * 1024 + ch0 + e] * x[e]; } }
#pragma unroll
    for (int e = 0; e < 16; ++e) o[e] = siluf_(o[e]);
}
template <int PASS>
__device__ __forceinline__ void mamba_pass(const Ctx& p, int layer, LAS unsigned char* tl, LAS unsigned char* lds, int team) {
    unsigned char* ws = p.wsp();
    const int tt0 = ltid() & 255;
    const bf16_t* PROJ = (const bf16_t*)(ws + OFF_PROJ);
    bf16_t* STG = (bf16_t*)(ws + OFF_R1);
    float* GDEC = (float*)(ws + OFF_GDEC);
    bf16_t* MIX = (bf16_t*)(p.outp() + OUT_MIX);
    const float* cw = p.in(27) + layer * 4096; const float* cb = p.in(28) + layer * 1024;
    LAS float* CS = (LAS float*)(tl + 73728);
    LAS float* DTv = (LAS float*)(tl + 73728 + 1024);
    LAS float* SSQX = (LAS float*)(lds + PTAB_OFF + 512);
    LAS bf16_t* XT = (LAS bf16_t*)(tl + 0); LAS bf16_t* BT = (LAS bf16_t*)(tl + 9216);
    LAS bf16_t* Bn = (LAS bf16_t*)(tl + 9216); LAS bf16_t* Cn = (LAS bf16_t*)(tl + 26624); LAS bf16_t* SC = (LAS bf16_t*)(tl + 44032); LAS float* YF = (LAS float*)(tl + 53248);
    for (int c = blockIdx.x; c < 256; c += gridDim.x) {
        const int gq = team, t0 = c * 64;
        int tt = tt0; asm volatile("" : "+v"(tt));
        const int wq = __builtin_amdgcn_readfirstlane(tt >> 6), lane = tt & 63, ti = wq >> 1, tj = wq & 1;
        const int t = tt >> 2, seg = tt & 3, gt = t0 + t;
        { const int h = 4 * gq + wq; const float dtr = bf2f(PROJ[(size_t)(t0 + lane) * PSTR + C_DT + h]) + p.in(29)[layer * 8 + h];
          const float dt = softplusf_(dtr); float da = -dt * __expf(p.in(30)[layer * 8 + h]);
#pragma unroll
          for (int o = 1; o < 64; o <<= 1) { const float n = shup(da, o); if (lane >= o) da += n; }
          CS[wq * 64 + lane] = da; DTv[wq * 64 + lane] = dt; }
#pragma unroll
        for (int hh = 0; hh < 2; ++hh) { const int n0 = hh * 64 + seg * 16; float bv[16];
            conv16(PROJ, gt, 512 + 128 * gq + n0, cw, cb, bv);
            if (PASS == 1) {
#pragma unroll
                for (int e = 0; e < 16; ++e) BT[(n0 + e) * TS + t] = f2bf(bv[e]);
            } else { st16_lds(Bn + t * BS_ + n0, bv); conv16(PROJ, gt, 768 + 128 * gq + n0, cw, cb, bv); st16_lds(Cn + t * BS_ + n0, bv); } }
        __syncthreads();
        float ssq_acc = 0.f; u32x4 hold[4][2];
#pragma unroll
        for (int h4 = 0; h4 < 4; ++h4) {
            const int h = 4 * gq + h4; const LAS float* cs = CS + h4 * 64;
            float xv[16];
            { const float cs63 = cs[63], cst = cs[t], dt = DTv[h4 * 64 + t];
              conv16(PROJ, gt, 64 * h + seg * 16, cw, cb, xv);
              const float f = (PASS == 1) ? dt * __expf(cs63 - cst) : dt;
#pragma unroll
              for (int e = 0; e < 16; ++e) XT[(seg * 16 + e) * TS + t] = f2bf(xv[e] * f);
              if (PASS == 1 && tt == 0) GDEC[c * 8 + h] = __expf(cs63); }
            __syncthreads();
            if (PASS == 1) {
                bf16_t* sg = STG + (size_t)(c * 8 + h) * 8192;
#pragma unroll
                for (int nn = 0; nn < 2; ++nn) { const int nt = tj * 2 + nn;
                    f32x16 a = mma_ll(zero16(), XT + ti * 32 * TS, TS, BT + nt * 32 * TS, TS, 64, lane);
                    const int n = nt * 32 + (lane & 31);
#pragma unroll
                    for (int j = 0; j < 16; ++j) { const int r = ti * 32 + ACC_ROW(j, lane); sg[r * 128 + n] = f2bf(a[j]); } }
            } else {
                float z[16]; ld16(PROJ + (size_t)gt * PSTR + C_Z + 64 * h + seg * 16, z);
                bf16x8 sfr[8];
                { const bf16_t* sp = STG + (size_t)(c * 8 + h) * 8192 + (size_t)(tj * 32 + (lane & 31)) * 128 + 8 * (lane >> 5);
#pragma unroll
                  for (int k = 0; k < 8; ++k) sfr[k] = *(const bf16x8*)(sp + 16 * k); }
                { f32x16 sc = mma_ll(zero16(), Cn + ti * 32 * BS_, BS_, Bn + tj * 32 * BS_, BS_, 128, lane);
                  const int s = tj * 32 + (lane & 31); const float css = cs[s];
#pragma unroll
                  for (int j = 0; j < 16; ++j) { const int r = ti * 32 + ACC_ROW(j, lane); SC[r * TS + s] = (s <= r) ? f2bf(sc[j] * __expf(cs[r] - css)) : (bf16_t)0; } }
                __syncthreads();
                { f32x16 yd = mma_ll(zero16(), SC + ti * 32 * TS, TS, XT + tj * 32 * TS, TS, 64, lane);
                  f32x16 yo = zero16();
                  { const LAS bf16_t* pa = Cn + (ti * 32 + (lane & 31)) * BS_ + 8 * (lane >> 5);
#pragma unroll
                    for (int k = 0; k < 8; ++k) yo = __builtin_amdgcn_mfma_f32_32x32x16_bf16(*(const LAS bf16x8*)(pa + 16 * k), sfr[k], yo, 0, 0, 0); }
                  const int pp = tj * 32 + (lane & 31);
#pragma unroll
                  for (int j = 0; j < 16; ++j) { const int r = ti * 32 + ACC_ROW(j, lane); YF[r * FS + pp] = yd[j] + __expf(cs[r]) * yo[j]; } }
                __syncthreads();
                { const float dsk = p.in(31)[layer * 8 + h]; float o[16]; float ss = 0.f;
#pragma unroll
                  for (int e = 0; e < 16; ++e) { const float y = YF[t * FS + seg * 16 + e] + xv[e] * dsk; o[e] = (DBG_ZERO & 4) ? 0.f : y * siluf_(z[e]); ss += o[e] * o[e]; }
                  ss += shx(ss, 1); ss += shx(ss, 2);
                  ssq_acc += ss; hold[h4][0] = pack8(o); hold[h4][1] = pack8(o + 8); }
            }
            __syncthreads();
        }
        if (PASS == 3) {
            if (seg == 0) SSQX[team * 64 + t] = ssq_acc;
            __syncthreads();
            const float rs = rsqrtf((SSQX[t] + SSQX[64 + t]) * (1.0f / 512.0f) + 1e-5f);
#pragma unroll
            for (int h4 = 0; h4 < 4; ++h4) { float o[16]; unpack8(hold[h4][0], o); unpack8(hold[h4][1], o + 8);
#pragma unroll
                for (int e = 0; e < 16; ++e) o[e] *= rs;
                st16_g(MIX + (size_t)gt * MIXW + 1024 + 64 * (4 * gq + h4) + seg * 16, o); }
            __syncthreads();
        }
    }
}
__device__ __forceinline__ void mamba_scan(const Ctx& p, int gtid) {
    bf16_t* STG = (bf16_t*)(p.wsp() + OFF_R1); const float* GDEC = (const float*)(p.wsp() + OFF_GDEC);
    const int h = gtid >> 13, pn = gtid & 8191; float st = 0.f;
#pragma unroll 1
    for (int c0 = 0; c0 < 256; c0 += 32) { float sv[32], gv[32];
#pragma unroll
        for (int j = 0; j < 32; ++j) { sv[j] = bf2f(STG[(size_t)((c0 + j) * 8 + h) * 8192 + pn]); gv[j] = GDEC[(c0 + j) * 8 + h]; }
#pragma unroll
        for (int j = 0; j < 32; ++j) { STG[(size_t)((c0 + j) * 8 + h) * 8192 + pn] = f2bf(st); st = st * gv[j] + sv[j]; } }
}


#if DBG_SLOWM
constexpr size_t OFF_DBGDT = WS_END + 4096;
__device__ __forceinline__ void mamba_slow_prep(const Ctx& p, int layer) {
    unsigned char* ws = p.wsp(); const bf16_t* PROJ = (const bf16_t*)(ws + OFF_PROJ); bf16_t* XBC = (bf16_t*)(ws + OFF_R1); float* DT = (float*)(ws + OFF_DBGDT);
    const float* cw = p.in(27) + layer * 4096; const float* cb = p.in(28) + layer * 1024;
    for (int i = blockIdx.x * 512 + ltid(); i < L_ * 64; i += gridDim.x * 512) { const int t = i >> 6, ch0 = (i & 63) * 16; float o[16];
        conv16(PROJ, t, ch0, cw, cb, o); st16_g(XBC + (size_t)t * 1024 + ch0, o);
        if ((i & 63) < 8) { const int h = i & 63; DT[t * 8 + h] = softplusf_(bf2f(PROJ[(size_t)t * PSTR + C_DT + h]) + p.in(29)[layer * 8 + h]); } }
}
__device__ __forceinline__ void mamba_slow_seq(const Ctx& p, int layer) {
    if (blockIdx.x >= 8 || ltid() >= 64) return;
    unsigned char* ws = p.wsp(); const bf16_t* PROJ = (const bf16_t*)(ws + OFF_PROJ); const bf16_t* XBC = (const bf16_t*)(ws + OFF_R1); const float* DT = (const float*)(ws + OFF_DBGDT);
    bf16_t* MIX = (bf16_t*)(p.outp() + OUT_MIX); float* SSQ = (float*)(ws + OFF_SSQ);
    const int h = blockIdx.x, pp = ltid() & 63, gq = h >> 2;
    const float A = -__expf(p.in(30)[layer * 8 + h]), dsk = p.in(31)[layer * 8 + h];
    float st[128];
#pragma unroll
    for (int n = 0; n < 128; ++n) st[n] = 0.f;
#pragma unroll 1
    for (int t = 0; t < L_; ++t) {
        const float dt = DT[t * 8 + h]; const float dec = __expf(dt * A);
        const float x = bf2f(XBC[(size_t)t * 1024 + 64 * h + pp]); const float xdt = x * dt; float y = 0.f;
        const bf16_t* Bp = XBC + (size_t)t * 1024 + 512 + 128 * gq; const bf16_t* Cp = XBC + (size_t)t * 1024 + 768 + 128 * gq;
#pragma unroll
        for (int n8 = 0; n8 < 128; n8 += 8) { float bv[8], cv[8]; unpack8(*(const u32x4*)(Bp + n8), bv); unpack8(*(const u32x4*)(Cp + n8), cv);
#pragma unroll
            for (int e = 0; e < 8; ++e) { st[n8 + e] = st[n8 + e] * dec + xdt * bv[e]; y += cv[e] * st[n8 + e]; } }
        const float z = bf2f(PROJ[(size_t)t * PSTR + C_Z + 64 * h + pp]);
        const float yg = (y + x * dsk) * siluf_(z); float ss = yg * yg;
#pragma unroll
        for (int o = 32; o > 0; o >>= 1) ss += shx(ss, o);
        if (pp == 0) SSQ[t * 8 + h] = ss;
        MIX[(size_t)t * MIXW + 1024 + 64 * h + pp] = f2bf(yg);
    }
}
#endif


#if DBG_SLOWS
__device__ __forceinline__ void s5_slow(const Ctx& p, int layer) {
    if (blockIdx.x >= 32 || ltid() >= 64) return;
    unsigned char* ws = p.wsp(); const bf16_t* PROJ = (const bf16_t*)(ws + OFF_PROJ); bf16_t* YB = (bf16_t*)(p.outp() + OUT_SEN);
    const int g = blockIdx.x, pp = ltid() & 63, gp = g * 64 + pp;
    const float dt = expf(p.in(4)[layer * 32 + g]); const float ar = p.in(5)[layer * 2048 + gp], ai = p.in(6)[layer * 2048 + gp];
    const float mag = expf(dt * ar); const float abr = mag * cosf(dt * ai), abi = mag * sinf(dt * ai);
    const float den = ar * ar + ai * ai; const float fre = ((abr - 1.0f) * ar + abi * ai) / den, fim = (abi * ar - (abr - 1.0f) * ai) / den;
    float bre[16], bim[16], cre[16], cim[16];
#pragma unroll
    for (int c = 0; c < 16; ++c) { const float br = p.in(7)[(size_t)layer * 32768 + gp * 16 + c], bi = p.in(8)[(size_t)layer * 32768 + gp * 16 + c];
        bre[c] = fre * br - fim * bi; bim[c] = fre * bi + fim * br;
        cre[c] = p.in(9)[(size_t)layer * 32768 + g * 1024 + c * 64 + pp]; cim[c] = p.in(10)[(size_t)layer * 32768 + g * 1024 + c * 64 + pp]; }
    const float dsk = pp < 16 ? p.in(11)[layer * 512 + g * 16 + pp] : 0.f;
    float sr = 0.f, si = 0.f;
#pragma unroll 1
    for (int t = 0; t < L_; ++t) {
        float u[16]; ld16(PROJ + (size_t)t * PSTR + C_S5U + 16 * g, u);
        float br = 0.f, bi = 0.f;
#pragma unroll
        for (int c = 0; c < 16; ++c) { br += u[c] * bre[c]; bi += u[c] * bim[c]; }
        const float nr = abr * sr - abi * si + br, ni = abr * si + abi * sr + bi; sr = nr; si = ni;
        float mine = 0.f;
#pragma unroll
        for (int c = 0; c < 16; ++c) { float v = cre[c] * sr - cim[c] * si;
#pragma unroll
            for (int o = 32; o > 0; o >>= 1) v += shx(v, o);
            if (pp == c) mine = v + dsk * u[c]; }
        if (pp < 16) { const float ge = 0.5f * mine * (1.0f + tanhf(0.7978845608f * (mine + 0.044715f * mine * mine * mine))); YB[(size_t)t * 512 + 16 * g + pp] = f2bf(ge); }
    }
}
#endif

template <int PASS>
__device__ __forceinline__ void s5_pass(const Ctx& p, int layer, LAS unsigned char* lds, int gw0, int nw) {
    unsigned char* ws = p.wsp();
    const int tid0 = ltid();
    bf16_t* PROJ = (bf16_t*)(ws + OFF_PROJ);
    const bf16_t* BB = (const bf16_t*)(ws + OFF_BB + lofs(layer)); const bf16_t* CC = (const bf16_t*)(ws + OFF_CC + lofs(layer));
    const float2* AB = (const float2*)(ws + OFF_ABAR + lofs(layer)); float2* S5E = (float2*)(ws + OFF_S5E);
    const int wib = __builtin_amdgcn_readfirstlane(tid0 >> 6);
    LAS bf16_t* BU = (LAS bf16_t*)(lds + wib * 17408);
    for (int wi0 = gw0; wi0 < 8192; wi0 += nw) {
        const bool valid = (wi0 + wib) < 8192; const int wi = valid ? wi0 + wib : 0;
        int tt = tid0; asm volatile("" : "+v"(tt));
        const int lane = tt & 63;
        const int c = wi >> 5, g = wi & 31, t0 = c * 64;
#pragma unroll
        for (int tr = 0; tr < 2; ++tr) {
            const bf16x8 a = *(const bf16x8*)(PROJ + (size_t)(t0 + tr * 32 + (lane & 31)) * PSTR + C_S5U + 16 * g + 8 * (lane >> 5));
#pragma unroll
            for (int qt = 0; qt < 4; ++qt) {
                const bf16x8 b = *(const bf16x8*)(BB + (size_t)(g * 128 + qt * 32 + (lane & 31)) * 16 + 8 * (lane >> 5));
                f32x16 r = __builtin_amdgcn_mfma_f32_32x32x16_bf16(a, b, zero16(), 0, 0, 0);
#pragma unroll
                for (int j = 0; j < 16; ++j) BU[(tr * 32 + ACC_ROW(j, lane)) * BS_ + qt * 32 + (lane & 31)] = f2bf(r[j]); } }
        __syncthreads();
        { const float2 ab = AB[g * 64 + lane]; float sr = 0.f, si = 0.f;
          if (PASS == 3) { const float2 s0 = S5E[(size_t)(c * 32 + g) * 64 + lane]; sr = s0.x; si = s0.y; }
#pragma unroll 1
          for (int tb = 0; tb < 64; tb += 8) { float brv[8], biv[8];
#pragma unroll
              for (int j = 0; j < 8; ++j) { brv[j] = bf2f(BU[(tb + j) * BS_ + lane]); biv[j] = bf2f(BU[(tb + j) * BS_ + 64 + lane]); }
#pragma unroll
              for (int j = 0; j < 8; ++j) { const float nr = ab.x * sr - ab.y * si + brv[j], ni = ab.x * si + ab.y * sr + biv[j]; sr = nr; si = ni;
                  if (PASS == 3) { BU[(tb + j) * BS_ + lane] = f2bf(sr); BU[(tb + j) * BS_ + 64 + lane] = f2bf(si); } } }
          if (PASS == 1 && valid) S5E[(size_t)(c * 32 + g) * 64 + lane] = make_float2(sr, si); }
        __syncthreads();
        if (PASS == 3) {
            const int cc = lane & 31;
#pragma unroll
            for (int tr = 0; tr < 2; ++tr) {
                f32x16 y = mma_lg(zero16(), BU + tr * 32 * BS_, BS_, CC + (size_t)(g * 32) * 128, 128, 128, lane);
                if (cc < 16 && valid) { const float dsk = p.in(11)[layer * 512 + g * 16 + cc];
#pragma unroll
                    for (int j = 0; j < 16; ++j) { const int gt = t0 + tr * 32 + ACC_ROW(j, lane);
                        bf16_t* up = PROJ + (size_t)gt * PSTR + C_S5U + 16 * g + cc;
                        const float v = y[j] + dsk * bf2f(*up);
                        *up = f2bf(0.5f * v * (1.0f + tanh_fast_(0.7978845608f * (v + 0.044715f * v * v * v)))); } } }
        }
        __syncthreads();
    }
}
__device__ __forceinline__ void s5_scan(const Ctx& p, int layer, int gtid) {
    float2* S5E = (float2*)(p.wsp() + OFF_S5E); const float2 a = ((const float2*)(p.wsp() + OFF_AB64 + lofs(layer)))[gtid];
    float sr = 0.f, si = 0.f;
#pragma unroll 1
    for (int c0 = 0; c0 < 256; c0 += 16) { float2 ev[16];
#pragma unroll
        for (int j = 0; j < 16; ++j) ev[j] = S5E[(size_t)(c0 + j) * 2048 + gtid];
#pragma unroll
        for (int j = 0; j < 16; ++j) { S5E[(size_t)(c0 + j) * 2048 + gtid] = make_float2(sr, si);
            const float nr = a.x * sr - a.y * si + ev[j].x, ni = a.x * si + a.y * sr + ev[j].y; sr = nr; si = ni; } }
}

static_assert(WS_END <= (size_t)256 * 1024 * 1024, "workspace overflow");
__global__ void __launch_bounds__(512, 2) mega_fwd(Params pa) {
    extern __shared__ __attribute__((aligned(16))) unsigned char smem[];
    LAS unsigned char* lds = (LAS unsigned char*)smem;
    cg::grid_group grid = cg::this_grid();
    const int team = __builtin_amdgcn_readfirstlane(ltid() >> 8), team_gid = blockIdx.x * 2 + team, nteams = gridDim.x * 2;
    LAS unsigned char* tl = lds + team * TEAM_LDS;
    if (ltid() == 0) { LAS unsigned long long* tw = (LAS unsigned long long*)(lds + PTAB_OFF);
#pragma unroll
        for (int i = 0; i < 35; ++i) tw[i] = (unsigned long long)pa.in[i]; }
    if (ltid() == 0) { ((LAS unsigned*)(lds + PTAB_OFF + 288))[0] = 0u; ((LAS unsigned*)(lds + PTAB_OFF + 288))[1] = 0u; }
    __syncthreads();
    const XcdBarrier xbar = xcd_barrier_post((unsigned*)(pa.ws + OFF_BAR), (volatile LAS unsigned*)(lds + PTAB_OFF + 288));
#if DBG_PROF
    if (blockIdx.x == 0 && ltid() == 0) { unsigned long long* a_ = (unsigned long long*)(pa.ws + OFF_PROF); a_[0] = 0ull; a_[1] = wall_clock64(); }
#endif
    Ctx p; p.tab = (LAS const unsigned*)(lds + PTAB_OFF); p.out = pa.out; p.ws = pa.ws;
    unsigned char* ws = p.ws;
    bf16_t* PROJ = (bf16_t*)(ws + OFF_PROJ); bf16_t* MIX = (bf16_t*)((unsigned char*)p.out + OUT_MIX);
    unsigned* gbar = (unsigned*)(ws + OFF_BAR); unsigned seam = 0;
#if USE_CG_SYNC
#define GSYNC() grid.sync()
#else
#define GSYNC() xcd_barrier(xbar)
#endif
    if (pa.ws == nullptr) grid.sync();
    unsigned* s5flag = (unsigned*)(ws + OFF_S5FLAG);
    for (int layer = 0; layer < 2; ++layer) {
        if (layer == 0) prep_weights(p, 0, lds, (int)blockIdx.x, (int)gridDim.x);
        prep_hb(p, layer);
        GSYNC();
        { pg8::Gemm g{(const bf16_t*)(ws + OFF_R1), (const bf16_t*)(ws + OFF_WIN), L_, NPAD, 1024, 1024}; pg8::StaticOrder S; S.init(L_, NPAD, (int)gridDim.x, (int)blockIdx.x);
          EpiProj E{PROJ}; pg8::gemm_phase<EpiProj, pg8::StaticOrder, false>(lds, g, S, E, nullptr); }
        GSYNC();
        rwkv_pass<1>(p, layer, tl, team_gid, nteams);
        s5_pass<1>(p, layer, lds, (int)blockIdx.x * 8, (int)gridDim.x * 8);
        GSYNC();
        if (blockIdx.x < 32) { if (ltid() < 64) rwkv_scan(p, blockIdx.x, lds); }
        else if (blockIdx.x < 36) s5_scan(p, layer, ((int)blockIdx.x - 32) * 512 + ltid());
        else if (layer == 0) prep_weights(p, 1, lds, (int)blockIdx.x - 36, (int)gridDim.x - 36);
        GSYNC();
        rwkv_pass<3>(p, layer, tl, team_gid, nteams);
        s5_pass<3>(p, layer, lds, (int)blockIdx.x * 8, (int)gridDim.x * 8);
        mamba_pass<1>(p, layer, tl, lds, team);
        GSYNC();
        if (blockIdx.x < 128) mamba_scan(p, (int)blockIdx.x * 512 + ltid());
        else { pg8::Gemm g{(const bf16_t*)(ws + OFF_PROJ) + C_S5U, (const bf16_t*)(ws + OFF_WGLU + lofs(layer)), L_, 512, 512, PSTR}; pg8::StaticOrder S; S.init(L_, 512, 128, (int)blockIdx.x - 128);
          EpiGlu E{MIX, PROJ, PROJ, p.in(13) + layer * 512}; pg8::gemm_phase<EpiGlu, pg8::StaticOrder, false>(lds, g, S, E, nullptr); }
        GSYNC();
        mamba_pass<3>(p, layer, tl, lds, team);
        GSYNC();
        { pg8::Gemm g{MIX, (const bf16_t*)(ws + OFF_WOUT + lofs(layer)), L_, 1024, 1536, 1536}; pg8::StaticOrder S; S.init(L_, 1024, (int)gridDim.x, (int)blockIdx.x);
          EpiD0 E{(bf16_t*)(ws + (layer == 0 ? OFF_D0 : OFF_PROJ))}; pg8::gemm_phase<EpiD0, pg8::StaticOrder, false>(lds, g, S, E, nullptr); }
        GSYNC();
    }
#if DBG_PROBE
    phase_probe(p);
    GSYNC();
#endif
    for (int xs_ = 0; xs_ < DBG_XSYNC; ++xs_) GSYNC();
    phase_final(p);
}

extern "C" void kernel_launch(void* const* d_in, const int* in_sizes, int n_in, void* d_out, int out_size, void* d_ws, size_t ws_size, hipStream_t stream) {
    static int grid_blocks = 0;
    if (!grid_blocks) {
        int dev = 0, cus = 0, per_cu = 0;
        hipGetDevice(&dev);
        hipDeviceGetAttribute(&cus, hipDeviceAttributeMultiprocessorCount, dev);
        hipFuncSetAttribute((const void*)mega_fwd, hipFuncAttributeMaxDynamicSharedMemorySize, LDS_BYTES);
        hipOccupancyMaxActiveBlocksPerMultiprocessor(&per_cu, (const void*)mega_fwd, 512, LDS_BYTES);
        int cap = cus * per_cu;
        grid_blocks = cap >= 256 ? 256 : -1;
        if (grid_blocks < 0) fprintf(stderr, "kernel_launch: resident capacity %d x %d < 256 workgroups\n", cus, per_cu);
        if (n_in != 35 || ws_size < ALT_END + (size_t)(1 << 20)) { fprintf(stderr, "kernel_launch: unexpected n_in %d / ws %zu\n", n_in, ws_size); grid_blocks = -1; }
    }
    if (grid_blocks < 0) return;
    (void)hipMemsetAsync((unsigned char*)d_ws + OFF_BAR, 0, 16384 + 256, stream);
    Params p{};
    for (int i = 0; i < 35; ++i) p.in[i] = (const float*)d_in[i];
    p.out = (float*)d_out; p.ws = (unsigned char*)d_ws;
    void* args[] = {&p};
    hipError_t e = hipLaunchCooperativeKernel((const void*)mega_fwd, dim3(grid_blocks), dim3(512), args, LDS_BYTES, stream);
    if (e != hipSuccess) fprintf(stderr, "cooperative launch failed: %s\n", hipGetErrorString(e));
}
```
